# Optimizing an MI355X kernel written in HIP

```python
import jax, jax.numpy as jnp
from jax import lax
import numpy as np

D_MODEL = 1024
BATCH = 32
SEQ = 2048
DEPTH = 4

CTX_LEN = 256
GRID_W = 64
N_EVEN = (DEPTH + 1) // 2
N_ODD = DEPTH // 2
RET_HEADS = 4
RET_DK = 128
RET_DV = 128
RET_CHUNK = 128
ATT_HEADS = 4
ATT_KV_HEADS = 2
ATT_HD = 128
Q_BLOCK = 128
ROPE_BASE = 10000.0
CM_WIDTH = 1024
CM_GROUPS = 8
CM_GROUP_DIM = CM_WIDTH // CM_GROUPS
CM_CHUNK = 128
FF_HIDDEN = 4 * D_MODEL
EPS = 1e-6
AB_SIZES = (RET_HEADS * RET_DK, RET_HEADS * RET_DK, RET_HEADS * RET_DV, RET_HEADS * RET_DV,
            ATT_HEADS * ATT_HD, ATT_KV_HEADS * ATT_HD, ATT_KV_HEADS * ATT_HD)
AB_IN_W = sum(AB_SIZES)
AB_OUT_W = RET_HEADS * RET_DV + ATT_HEADS * ATT_HD

kernel_name = 'hybrid_retention_gqa_chunkmlp_dit'


def rms_norm(x, g):
    xf = x.astype(jnp.float32)
    y = xf * lax.rsqrt(jnp.mean(xf * xf, axis=-1, keepdims=True) + EPS)
    return (y * g.astype(jnp.float32)).astype(x.dtype)


def modulate(h, shift, scale):
    return h * (1.0 + scale) + shift


def grid_rope(L, hd):
    rows = L // GRID_W
    row = jnp.repeat(jnp.arange(rows, dtype=jnp.float32), GRID_W)
    col = jnp.tile(jnp.arange(GRID_W, dtype=jnp.float32), rows)
    n_freq = hd // 4
    inv = ROPE_BASE ** (-jnp.arange(n_freq, dtype=jnp.float32) / n_freq)
    ang = jnp.concatenate([row[:, None] * inv[None, :], col[:, None] * inv[None, :]], axis=-1)
    return jnp.cos(ang), jnp.sin(ang)


def apply_rope(x, cos, sin):
    half = x.shape[-1] // 2
    x1, x2 = x[..., :half], x[..., half:]
    cs, sn = cos[None, :, None, :], sin[None, :, None, :]
    out = jnp.concatenate([x1 * cs - x2 * sn, x1 * sn + x2 * cs], axis=-1)
    return out.astype(x.dtype)


def split_heads(t, n, d):
    return t.reshape(t.shape[0], t.shape[1], n, d)


def split_ab(p):
    out, start = [], 0
    for s in AB_SIZES:
        out.append(p[..., start:start + s])
        start += s
    return out


def retention_chunkwise(q, k, v, log_gamma, state0):
    B, L, H, dk = q.shape
    dv = v.shape[-1]
    C = RET_CHUNK
    N = L // C
    qc = q.reshape(B, N, C, H, dk)
    kc = k.reshape(B, N, C, H, dk)
    vc = v.reshape(B, N, C, H, dv)
    pos = jnp.arange(C, dtype=jnp.float32)
    rel = pos[:, None] - pos[None, :]
    decay = jnp.where((rel >= 0)[None], jnp.exp(jnp.maximum(rel, 0.0)[None] * log_gamma[:, None, None]), 0.0)
    scores = jnp.einsum('bnihd,bnjhd->bnhij', qc, kc) * decay
    intra = jnp.einsum('bnhij,bnjhe->bnihe', scores, vc)
    k_decay = jnp.exp((C - 1.0 - pos)[:, None] * log_gamma[None, :])
    q_decay = jnp.exp((pos + 1.0)[:, None] * log_gamma[None, :])
    chunk_decay = jnp.exp(C * log_gamma)[None, :, None, None]
    chunk_kv = jnp.einsum('bnjhd,jh,bnjhe->nbhde', kc, k_decay, vc)

    def step(state, kv_n):
        return chunk_decay * state + kv_n, state

    state_final, state_prev = lax.scan(step, state0, chunk_kv)
    cross = jnp.einsum('bnihd,nbhde->bnihe', qc, state_prev) * q_decay[None, None, :, :, None]
    return (intra + cross).reshape(B, L, H, dv), state_final


def retention_out(o, g):
    B, L, H, dv = o.shape
    of = o.astype(jnp.float32)
    mu = jnp.mean(of, axis=-1, keepdims=True)
    var = jnp.mean(jnp.square(of - mu), axis=-1, keepdims=True)
    y = ((of - mu) * lax.rsqrt(var + EPS)).reshape(B, L, H * dv)
    return y.astype(g.dtype) * jax.nn.silu(g)


def block_attention(q, k, v):
    B, Lq, H, hd = q.shape
    KV = k.shape[2]
    G = H // KV
    nb = Lq // Q_BLOCK
    scale = hd ** -0.5
    qb = q.reshape(B, nb, Q_BLOCK, KV, G, hd).transpose(1, 0, 2, 3, 4, 5)

    def one_block(qi):
        s = jnp.einsum('bqkgd,bskd->bkgqs', qi, k).astype(jnp.float32) * scale
        p = jax.nn.softmax(s, axis=-1)
        return jnp.einsum('bkgqs,bskd->bqkgd', p.astype(v.dtype), v)

    o = lax.map(one_block, qb)
    return o.transpose(1, 0, 2, 3, 4, 5).reshape(B, Lq, H * hd)


def mix_ab(h_lat, h_ctx, w_in, w_out, ret_decay, q_g, k_g):
    B, L, _ = h_lat.shape
    cos_r, sin_r = grid_rope(L, RET_DK)
    cos_a, sin_a = grid_rope(L, ATT_HD)
    lat = split_ab(h_lat @ w_in)
    ctx = split_ab(h_ctx @ w_in)
    flip = lambda t: jnp.flip(t, axis=1)
    rq_l = apply_rope(split_heads(lat[0], RET_HEADS, RET_DK), cos_r, sin_r)
    rk_l = apply_rope(split_heads(lat[1], RET_HEADS, RET_DK), cos_r, sin_r) * (RET_DK ** -0.5)
    rv_l = split_heads(lat[2], RET_HEADS, RET_DV)
    rq_c = split_heads(ctx[0], RET_HEADS, RET_DK)
    rk_c = split_heads(ctx[1], RET_HEADS, RET_DK) * (RET_DK ** -0.5)
    rv_c = split_heads(ctx[2], RET_HEADS, RET_DV)
    log_gamma = jax.nn.log_sigmoid(ret_decay.astype(jnp.float32))
    zero = jnp.zeros((B, RET_HEADS, RET_DK, RET_DV), jnp.float32)
    oc_f, st_f = retention_chunkwise(rq_c, rk_c, rv_c, log_gamma[0], zero)
    ol_f, _ = retention_chunkwise(rq_l, rk_l, rv_l, log_gamma[0], st_f)
    oc_b, st_b = retention_chunkwise(flip(rq_c), flip(rk_c), flip(rv_c), log_gamma[1], zero)
    ol_b, _ = retention_chunkwise(flip(rq_l), flip(rk_l), flip(rv_l), log_gamma[1], st_b)
    ret_l = retention_out(ol_f + flip(ol_b), lat[3])
    ret_c = retention_out(oc_f + flip(oc_b), ctx[3])
    aq_l = apply_rope(rms_norm(split_heads(lat[4], ATT_HEADS, ATT_HD), q_g), cos_a, sin_a)
    ak_l = apply_rope(rms_norm(split_heads(lat[5], ATT_KV_HEADS, ATT_HD), k_g), cos_a, sin_a)
    av_l = split_heads(lat[6], ATT_KV_HEADS, ATT_HD)
    aq_c = rms_norm(split_heads(ctx[4], ATT_HEADS, ATT_HD), q_g)
    ak_c = rms_norm(split_heads(ctx[5], ATT_KV_HEADS, ATT_HD), k_g)
    av_c = split_heads(ctx[6], ATT_KV_HEADS, ATT_HD)
    att_l = block_attention(aq_l, jnp.concatenate([ak_c, ak_l], axis=1), jnp.concatenate([av_c, av_l], axis=1))
    att_c = block_attention(aq_c, ak_c, av_c)
    out_l = jnp.concatenate([ret_l, att_l], axis=-1) @ w_out
    out_c = jnp.concatenate([ret_c, att_c], axis=-1) @ w_out
    return out_l, out_c


def mix_chunk_mlp(h, w_in, v_g, w_s, b_s, w_out):
    B, L, _ = h.shape
    z = jax.nn.gelu(h @ w_in)
    u, v = z[..., :CM_WIDTH], z[..., CM_WIDTH:]
    v = rms_norm(v, v_g)
    vc = v.reshape(B, L // CM_CHUNK, CM_CHUNK, CM_GROUPS, CM_GROUP_DIM)
    sv = jnp.einsum('gpq,bnqgd->bnpgd', w_s, vc) + b_s.T[None, None, :, :, None]
    return (u * sv.reshape(B, L, CM_WIDTH)) @ w_out


def sq_relu_mlp(h, w1, w2):
    return jnp.square(jax.nn.relu(h @ w1)) @ w2


def setup_inputs(seed: int = 0) -> dict:
    key = jax.random.key(seed)
    ks = jax.random.split(key, 24)
    f32 = jnp.float32

    def nrm(k, shape, scale):
        return jax.random.normal(k, shape, f32) * scale

    def gain(k, shape):
        return 1.0 + 0.01 * jax.random.normal(k, shape, f32)

    base = 1.0 - 2.0 ** (-5.0 - jnp.arange(RET_HEADS, dtype=f32))
    logit = jnp.log(base) - jnp.log1p(-base)
    ret_decay = logit[None, None, :] + 0.05 * jax.random.normal(ks[10], (N_EVEN, 2, RET_HEADS), f32)
    return {
        'x': nrm(ks[0], (BATCH, SEQ, D_MODEL), 1.0),
        'c': nrm(ks[1], (BATCH, D_MODEL), 1.0),
        'ctx': nrm(ks[2], (BATCH, CTX_LEN, D_MODEL), 1.0),
        'c_ctx': nrm(ks[3], (D_MODEL,), 1.0),
        'mod_w': nrm(ks[4], (DEPTH, D_MODEL, 6 * D_MODEL), D_MODEL ** -0.5),
        'mod_b': nrm(ks[5], (DEPTH, 6 * D_MODEL), 0.01),
        'norm1_g': gain(ks[6], (DEPTH, D_MODEL)),
        'norm2_g': gain(ks[7], (DEPTH, D_MODEL)),
        'ab_w_in': nrm(ks[8], (N_EVEN, D_MODEL, AB_IN_W), D_MODEL ** -0.5),
        'ab_w_out': nrm(ks[9], (N_EVEN, AB_OUT_W, D_MODEL), AB_OUT_W ** -0.5),
        'ret_decay': ret_decay,
        'att_q_norm_g': gain(ks[11], (N_EVEN, ATT_HD)),
        'att_k_norm_g': gain(ks[12], (N_EVEN, ATT_HD)),
        'cm_w_in': nrm(ks[13], (N_ODD, D_MODEL, 2 * CM_WIDTH), D_MODEL ** -0.5),
        'cm_v_norm_g': gain(ks[14], (N_ODD, CM_WIDTH)),
        'cm_w_s': nrm(ks[15], (N_ODD, CM_GROUPS, CM_CHUNK, CM_CHUNK), CM_CHUNK ** -0.5),
        'cm_b_s': gain(ks[16], (N_ODD, CM_GROUPS, CM_CHUNK)),
        'cm_w_out': nrm(ks[17], (N_ODD, CM_WIDTH, D_MODEL), CM_WIDTH ** -0.5),
        'ff_w1': nrm(ks[18], (DEPTH, D_MODEL, FF_HIDDEN), D_MODEL ** -0.5),
        'ff_w2': nrm(ks[19], (DEPTH, FF_HIDDEN, D_MODEL), FF_HIDDEN ** -0.5),
    }


def reference(x, c, ctx, c_ctx, mod_w, mod_b, norm1_g, norm2_g, ab_w_in, ab_w_out, ret_decay,
              att_q_norm_g, att_k_norm_g, cm_w_in, cm_v_norm_g, cm_w_s, cm_b_s, cm_w_out, ff_w1, ff_w2):
    silu_c = jax.nn.silu(c)
    silu_cc = jax.nn.silu(c_ctx)
    h_stream = ctx
    for l in range(DEPTH):
        last = l == DEPTH - 1
        is_even = l % 2 == 0
        i = l // 2
        mod_lat = (silu_c @ mod_w[l] + mod_b[l])[:, None, :]
        mod_ctx = silu_cc @ mod_w[l] + mod_b[l]
        sh1, sc1, g1, sh2, sc2, g2 = jnp.split(mod_lat, 6, axis=-1)
        csh1, csc1, cg1, csh2, csc2, cg2 = jnp.split(mod_ctx, 6, axis=-1)
        h_lat = modulate(rms_norm(x, norm1_g[l]), sh1, sc1)
        if is_even or not last:
            h_ctx = modulate(rms_norm(h_stream, norm1_g[l]), csh1, csc1)
        if is_even:
            o_lat, o_ctx = mix_ab(h_lat, h_ctx, ab_w_in[i], ab_w_out[i], ret_decay[i],
                                  att_q_norm_g[i], att_k_norm_g[i])
        else:
            o_lat = mix_chunk_mlp(h_lat, cm_w_in[i], cm_v_norm_g[i], cm_w_s[i], cm_b_s[i], cm_w_out[i])
            if not last:
                o_ctx = mix_chunk_mlp(h_ctx, cm_w_in[i], cm_v_norm_g[i], cm_w_s[i], cm_b_s[i], cm_w_out[i])
        x = x + g1 * o_lat
        x = x + g2 * sq_relu_mlp(modulate(rms_norm(x, norm2_g[l]), sh2, sc2), ff_w1[l], ff_w2[l])
        if not last:
            h_stream = h_stream + cg1 * o_ctx
            h_stream = h_stream + cg2 * sq_relu_mlp(modulate(rms_norm(h_stream, norm2_g[l]), csh2, csc2),
                                                     ff_w1[l], ff_w2[l])
    return x
```

```cpp
#include <hip/hip_runtime.h>
#include <hip/hip_cooperative_groups.h>
#include <cstdio>
#include <cstdint>
namespace cg = cooperative_groups;

namespace pg8 {
#define PG8_LAS __attribute__((address_space(3)))
typedef unsigned short bf16_t;
typedef short bf16x8 __attribute__((ext_vector_type(8)));
typedef float f32x4 __attribute__((ext_vector_type(4)));
typedef unsigned u32x4 __attribute__((ext_vector_type(4)));
constexpr int BM = 256, BK = 64, HALF = 128, HTB = HALF * BK * 2, STAGE_BYTES = 8 * HTB, NXCD = 8, WGM = 8;

__host__ __device__ __forceinline__ int lds_byte(int r, int c) { const int st = (r >> 4) * 2 + (c >> 5), rr = r & 15, cc = c & 31, ob = rr * 64 + cc * 2; return st * 1024 + (ob ^ (((ob >> 9) & 1) << 5)); }
__host__ __device__ __forceinline__ void stage_rc(int b, int& R, int& C) { const int st = b / 1024, sb = b % 1024, swz = sb ^ (((sb >> 9) & 1) << 5); R = (st >> 1) * 16 + swz / 64; C = (st & 1) * 32 + (swz % 64) / 2; }
__host__ __device__ __forceinline__ int perm32(int rho) { const int n = rho >> 4, i = rho & 15; return 8 * (i >> 2) + 4 * n + (i & 3); }

struct Unit { int pm, pn; };
struct Gemm { const bf16_t* A; const bf16_t* Bt; int M, N, K; };

struct StaticOrder {
    int nM, nN, nwg, G, c;
    __host__ __device__ void init(int M, int N, int G_, int c_) { nM = M / BM; nN = N / BM; nwg = nM * nN; G = G_; c = c_; }
    __host__ __device__ bool next(int i, Unit& u) const {
        const long L = (long)i * G + c; if (L >= nwg) return false;
        int wgid = (int)L; { const int q = nwg / NXCD, r = nwg % NXCD, xcd = wgid % NXCD, off = wgid / NXCD; wgid = (xcd < r ? xcd * (q + 1) : r * (q + 1) + (xcd - r) * q) + off; }
        const int nig = WGM * nN, gid = wgid / nig, fm = gid * WGM, gsz = (nM - fm) < WGM ? (nM - fm) : WGM;
        u.pm = fm + ((wgid % nig) % gsz); u.pn = (wgid % nig) / gsz; return true;
    }
    __device__ __forceinline__ void a_ready(const Unit&) const {}
    __device__ __forceinline__ void done(const Unit&) const {}
};

__device__ __forceinline__ unsigned cvt_pk_bf16(float lo, float hi) { unsigned r; asm volatile("v_cvt_pk_bf16_f32 %0, %1, %2" : "=v"(r) : "v"(lo), "v"(hi)); return r; }
__device__ __forceinline__ float gelu_tanh(float x) {
    const float u = 0.7978845608f * (x + 0.044715f * x * x * x);
    const float e = __builtin_amdgcn_exp2f(-2.885390082f * u);
    return x * __builtin_amdgcn_rcpf(1.0f + e);
}
constexpr int RLAT_ROWS = 65536;
template <int ACT> struct EpiBf16 {
    static constexpr bool PERM = true, AFTER_DRAIN = false;
    bf16_t* O; int ldc; float* ssq;
    __device__ __forceinline__ void operator()(const f32x4 (&acc)[2][2][4][2], const Unit& u, int wr, int wc, int fr, int fq) const {
        const int row0 = u.pm * BM + wr * 64 + fr; const int col0 = u.pn * BM + wc * 32 + 8 * fq;
        const bool dossq = (ACT == 1) && (u.pn >= 4);
#pragma unroll
        for (int ai = 0; ai < 2; ++ai)
#pragma unroll
            for (int m = 0; m < 4; ++m) { bf16_t* rowp = O + (size_t)(row0 + ai * HALF + m * 16) * ldc + col0; float ss = 0.f;
#pragma unroll
                for (int bj = 0; bj < 2; ++bj) { f32x4 v0 = acc[ai][bj][m][0], v1 = acc[ai][bj][m][1];
                    if (ACT == 1) {
#pragma unroll
                        for (int e = 0; e < 4; ++e) { v0[e] = gelu_tanh(v0[e]); v1[e] = gelu_tanh(v1[e]); }
                        ss += (v0[0] * v0[0] + v0[1] * v0[1]) + (v0[2] * v0[2] + v0[3] * v0[3]) + (v1[0] * v1[0] + v1[1] * v1[1]) + (v1[2] * v1[2] + v1[3] * v1[3]);
                    }
                    if (ACT == 2) {
#pragma unroll
                        for (int e = 0; e < 4; ++e) { const float a = fmaxf(v0[e], 0.f), b = fmaxf(v1[e], 0.f); v0[e] = a * a; v1[e] = b * b; }
                    }
                    u32x4 w; w.x = cvt_pk_bf16(v0[0], v0[1]); w.y = cvt_pk_bf16(v0[2], v0[3]); w.z = cvt_pk_bf16(v1[0], v1[1]); w.w = cvt_pk_bf16(v1[2], v1[3]);
                    *(u32x4*)(rowp + bj * HALF) = w; }
                if (ACT == 1) { if (dossq) { ss += __shfl_xor(ss, 16); ss += __shfl_xor(ss, 32);
                    if (fq == 0) ssq[(size_t)(row0 + ai * HALF + m * 16) * 16 + (u.pn - 4) * 4 + wc] = ss; } }
            }
    }
};
struct EpiGate {
    static constexpr bool PERM = false, AFTER_DRAIN = false;
    const float* xin_lat; const float* xin_ctx; float* xout_lat; float* xout_ctx; const float* modg;
    __device__ __forceinline__ void operator()(const f32x4 (&acc)[2][2][4][2], const Unit& u, int wr, int wc, int fr, int fq) const {
        const bool lat = u.pm < 256; const int bidx = lat ? (u.pm >> 3) : 32;
        const float* xi = lat ? xin_lat + (size_t)u.pm * BM * 1024 : xin_ctx + (size_t)(u.pm - 256) * BM * 1024;
        float* xo = lat ? xout_lat + (size_t)u.pm * BM * 1024 : xout_ctx + (size_t)(u.pm - 256) * BM * 1024;
        const int col0 = u.pn * BM + wc * 32 + 4 * fq;
        const float* gp = modg + (size_t)bidx * 6144 + col0;
        f32x4 gv[2][2];
#pragma unroll
        for (int bj = 0; bj < 2; ++bj)
#pragma unroll
            for (int n = 0; n < 2; ++n) gv[bj][n] = *(const f32x4*)(gp + bj * HALF + n * 16);
#pragma unroll
        for (int ai = 0; ai < 2; ++ai)
#pragma unroll
            for (int m = 0; m < 4; ++m) { const size_t off = (size_t)(wr * 64 + fr + ai * HALF + m * 16) * 1024 + col0;
#pragma unroll
                for (int bj = 0; bj < 2; ++bj)
#pragma unroll
                    for (int n = 0; n < 2; ++n) { const f32x4 xv = *(const f32x4*)(xi + off + bj * HALF + n * 16);
                        *(f32x4*)(xo + off + bj * HALF + n * 16) = xv + gv[bj][n] * acc[ai][bj][m][n]; }
                if (m & 1) asm volatile("" ::: "memory"); }
    }
};

template <class Epi, class Sched, bool ALIGN_EPI = false, bool SP2 = false>
__device__ __forceinline__ void gemm_phase(PG8_LAS unsigned char* lds, const Gemm g, const Sched& S, const Epi& E) {
    int tid_ = threadIdx.x; asm volatile("" : "+v"(tid_));
    const int tid = tid_, wid = __builtin_amdgcn_readfirstlane(tid >> 6), lane = tid & 63, wr = wid >> 2, wc = wid & 3, fr = lane & 15, fq = lane >> 4;
    const int K = g.K, nt = K / BK;
    unsigned voffA[2], voffB[2];
#pragma unroll
    for (int i = 0; i < 2; ++i) { int R, C; stage_rc(tid * 16 + i * 8192, R, C); const int Rb = Epi::PERM ? ((R & ~31) + perm32(R & 31)) : R;
        voffA[i] = (unsigned)(R * K + C) * 2u; voffB[i] = (unsigned)(Rb * K + C) * 2u; }
    const size_t kstep = (size_t)(BK * 2);
    const size_t hstep = (size_t)HALF * K * 2;
    const size_t tstep = 2 * hstep;
    const unsigned ldsw = (unsigned)wid * 1024u;
    const int aoff = lds_byte(wr * 64 + fr, fq * 8), boff = lds_byte(wc * 32 + fr, fq * 8);
#define PG8_SA(b, h) (((b) * 2 + (h)) * HTB)
#define PG8_SB(b, h) ((4 + (b) * 2 + (h)) * HTB)
#define PG8_STAGE(bufoff, gbase, voff) do { _Pragma("unroll") for (int _i = 0; _i < 2; ++_i) \
        __builtin_amdgcn_global_load_lds((const unsigned*)((const char*)(gbase) + (voff)[_i]), (PG8_LAS unsigned*)(lds + (bufoff) + ldsw + _i * 8192), 16, 0, 0); } while (0)
#define PG8_LDA(dst, b, h) do { _Pragma("unroll") for (int m = 0; m < 4; ++m) _Pragma("unroll") for (int k = 0; k < 2; ++k) dst[m][k] = *(const PG8_LAS bf16x8*)(lds + PG8_SA(b, h) + aoff + m * 2048 + k * 1024); } while (0)
#define PG8_LDB(dst, b, h) do { _Pragma("unroll") for (int n = 0; n < 2; ++n) _Pragma("unroll") for (int k = 0; k < 2; ++k) dst[n][k] = *(const PG8_LAS bf16x8*)(lds + PG8_SB(b, h) + boff + n * 2048 + k * 1024); } while (0)
#define PG8_MMA(ai, bj, At, Bt) do { __builtin_amdgcn_s_setprio(1); _Pragma("unroll") for (int m = 0; m < 4; ++m) _Pragma("unroll") for (int n = 0; n < 2; ++n) _Pragma("unroll") for (int k = 0; k < 2; ++k) \
        acc[ai][bj][m][n] = __builtin_amdgcn_mfma_f32_16x16x32_bf16(Bt[n][k], At[m][k], acc[ai][bj][m][n], 0, 0, 0); __builtin_amdgcn_s_setprio(0); } while (0)
#define PG8_WAIT_V(n) asm volatile("s_waitcnt vmcnt(" #n ")" ::: "memory")
#define PG8_WAIT_L(n) asm volatile("s_waitcnt lgkmcnt(" #n ")" ::: "memory")
#define PG8_BAR __builtin_amdgcn_s_barrier()
#define PG8_SCHED __builtin_amdgcn_sched_barrier(0)
    Unit cur, nxt; int ui = 0;
    if (!S.next(0, cur)) return;
    f32x4 acc[2][2][4][2];
#pragma unroll
    for (int a = 0; a < 2; ++a)
#pragma unroll
        for (int b = 0; b < 2; ++b)
#pragma unroll
            for (int m = 0; m < 4; ++m)
#pragma unroll
                for (int n = 0; n < 2; ++n) acc[a][b][m][n] = (f32x4){0.f, 0.f, 0.f, 0.f};
    bf16x8 At[4][2], B0[2][2], B1[2][2];
    const char* cA = (const char*)g.A + (size_t)cur.pm * tstep; const char* cB = (const char*)g.Bt + (size_t)cur.pn * tstep;
    S.a_ready(cur);
    if constexpr (SP2) {
        PG8_STAGE(PG8_SB(0, 0), cB, voffB); PG8_STAGE(PG8_SB(0, 1), cB + hstep, voffB); PG8_STAGE(PG8_SA(0, 0), cA, voffA); PG8_STAGE(PG8_SA(0, 1), cA + hstep, voffA);
        if (wr == 1) PG8_BAR;
        PG8_WAIT_V(2); PG8_BAR;
        PG8_STAGE(PG8_SB(1, 0), cB + kstep, voffB); PG8_STAGE(PG8_SA(1, 0), cA + kstep, voffA); PG8_STAGE(PG8_SB(1, 1), cB + hstep + kstep, voffB);
        PG8_WAIT_V(6); PG8_BAR;
    } else {
        PG8_STAGE(PG8_SB(0, 0), cB, voffB); PG8_STAGE(PG8_SA(0, 0), cA, voffA); PG8_STAGE(PG8_SB(0, 1), cB + hstep, voffB); PG8_STAGE(PG8_SA(0, 1), cA + hstep, voffA);
        if (wr == 1) PG8_BAR;
        PG8_WAIT_V(4); PG8_BAR;
        PG8_STAGE(PG8_SB(1, 0), cB + kstep, voffB); PG8_STAGE(PG8_SA(1, 0), cA + kstep, voffA); PG8_STAGE(PG8_SB(1, 1), cB + hstep + kstep, voffB);
        PG8_WAIT_V(6); PG8_BAR;
    }
    for (;;) {
        const bool has_next = S.next(ui + 1, nxt);
        const char* nA = has_next ? (const char*)g.A + (size_t)nxt.pm * tstep : cA; const char* nB = has_next ? (const char*)g.Bt + (size_t)nxt.pn * tstep : cB;
        for (int t = 0; t < nt; t += 2) {
            const bool last = (t == nt - 2);
            const char* a1 = cA + (size_t)(t + 1) * kstep;
            const char* a2 = last ? nA : cA + (size_t)(t + 2) * kstep; const char* b2 = last ? nB : cB + (size_t)(t + 2) * kstep;
            const char* a3 = a2 + kstep; const char* b3 = b2 + kstep;
            if (last && has_next) S.a_ready(nxt);
            if constexpr (SP2) {
            PG8_LDB(B0, 0, 0); PG8_LDB(B1, 0, 1); PG8_SCHED; PG8_LDA(At, 0, 0); PG8_STAGE(PG8_SA(1, 1), a1 + hstep, voffA);
            PG8_WAIT_V(8); PG8_WAIT_L(0); PG8_BAR; PG8_MMA(0, 0, At, B0); PG8_MMA(0, 1, At, B1); PG8_BAR; PG8_SCHED;
            PG8_LDA(At, 0, 1); PG8_STAGE(PG8_SB(0, 0), b2, voffB); PG8_STAGE(PG8_SB(0, 1), b2 + hstep, voffB); PG8_STAGE(PG8_SA(0, 0), a2, voffA);
            PG8_WAIT_V(8); PG8_WAIT_L(0); PG8_BAR; PG8_MMA(1, 0, At, B0); PG8_MMA(1, 1, At, B1); PG8_BAR; PG8_SCHED;
            PG8_LDB(B0, 1, 0); PG8_LDB(B1, 1, 1); PG8_SCHED; PG8_LDA(At, 1, 0); PG8_STAGE(PG8_SA(0, 1), a2 + hstep, voffA);
            PG8_WAIT_V(8); PG8_WAIT_L(0); PG8_BAR; PG8_MMA(0, 0, At, B0); PG8_MMA(0, 1, At, B1); PG8_BAR; PG8_SCHED;
            PG8_LDA(At, 1, 1); PG8_STAGE(PG8_SB(1, 0), b3, voffB); PG8_STAGE(PG8_SB(1, 1), b3 + hstep, voffB); PG8_STAGE(PG8_SA(1, 0), a3, voffA);
            PG8_WAIT_V(8); PG8_WAIT_L(0); PG8_BAR; PG8_MMA(1, 0, At, B0); PG8_MMA(1, 1, At, B1); PG8_BAR; PG8_SCHED;
            } else {
            PG8_LDB(B0, 0, 0); PG8_SCHED; PG8_LDA(At, 0, 0); PG8_STAGE(PG8_SA(1, 1), a1 + hstep, voffA);
            PG8_WAIT_L(8); PG8_BAR; PG8_WAIT_L(0); PG8_MMA(0, 0, At, B0); PG8_BAR; PG8_SCHED;
            PG8_LDB(B1, 0, 1); PG8_STAGE(PG8_SB(0, 0), b2, voffB);
            PG8_BAR; PG8_WAIT_L(0); PG8_MMA(0, 1, At, B1); PG8_BAR;
            PG8_LDA(At, 0, 1); PG8_STAGE(PG8_SA(0, 0), a2, voffA);
            PG8_BAR; PG8_WAIT_L(0); PG8_MMA(1, 0, At, B0); PG8_BAR; PG8_SCHED;
            PG8_STAGE(PG8_SB(0, 1), b2 + hstep, voffB);
            PG8_WAIT_V(6); PG8_BAR; PG8_MMA(1, 1, At, B1); PG8_BAR;
            PG8_LDB(B0, 1, 0); PG8_SCHED; PG8_LDA(At, 1, 0); PG8_STAGE(PG8_SA(0, 1), a2 + hstep, voffA);
            PG8_WAIT_L(8); PG8_BAR; PG8_WAIT_L(0); PG8_MMA(0, 0, At, B0); PG8_BAR; PG8_SCHED;
            PG8_LDB(B1, 1, 1); PG8_STAGE(PG8_SB(1, 0), b3, voffB);
            PG8_BAR; PG8_WAIT_L(0); PG8_MMA(0, 1, At, B1); PG8_BAR;
            PG8_LDA(At, 1, 1); PG8_STAGE(PG8_SA(1, 0), a3, voffA);
            PG8_BAR; PG8_WAIT_L(0); PG8_MMA(1, 0, At, B0); PG8_BAR; PG8_SCHED;
            PG8_STAGE(PG8_SB(1, 1), b3 + hstep, voffB);
            PG8_WAIT_V(6); PG8_BAR; PG8_MMA(1, 1, At, B1); PG8_BAR;
            }
        }
        if constexpr (ALIGN_EPI) { if (wr == 0) PG8_BAR; }
        if constexpr (!Epi::AFTER_DRAIN) { E(acc, cur, wr, wc, fr, fq); S.done(cur); }
        if (!has_next) break;
#pragma unroll
        for (int a = 0; a < 2; ++a)
#pragma unroll
            for (int b = 0; b < 2; ++b)
#pragma unroll
                for (int m = 0; m < 4; ++m)
#pragma unroll
                    for (int n = 0; n < 2; ++n) acc[a][b][m][n] = (f32x4){0.f, 0.f, 0.f, 0.f};
        cur = nxt; cA = nA; cB = nB; ++ui;
        if constexpr (ALIGN_EPI) { if (wr == 1) PG8_BAR; }
    }
    PG8_WAIT_V(0);
    if constexpr (!ALIGN_EPI) { if (wr == 0) PG8_BAR; }
    PG8_BAR;
    if constexpr (Epi::AFTER_DRAIN) { E.fused(acc, cur, wr, wc, fr, fq, lds, wid, lane); S.done(cur); }
#undef PG8_SA
#undef PG8_SB
#undef PG8_STAGE
#undef PG8_LDA
#undef PG8_LDB
#undef PG8_MMA
#undef PG8_WAIT_V
#undef PG8_WAIT_L
#undef PG8_BAR
#undef PG8_SCHED
}}

typedef unsigned short bf16_t;
typedef float f32x4 __attribute__((ext_vector_type(4)));
typedef unsigned u32x4 __attribute__((ext_vector_type(4)));
typedef unsigned u32x2 __attribute__((ext_vector_type(2)));
using bf16x8 = __attribute__((ext_vector_type(8))) short;
using s16x4  = __attribute__((ext_vector_type(4))) short;
using f32x16 = __attribute__((ext_vector_type(16))) float;

constexpr int DM = 1024, NB = 32, SEQ = 2048, CTXL = 256, DEPTH = 4, NIN = 3072, FF = 4096;
constexpr int RLAT = NB * SEQ, RCTX = NB * CTXL, RTOT = RLAT + RCTX;
constexpr float EPS = 1e-6f;
constexpr size_t MiB = 1u << 20;
constexpr size_t WS_MOD = 1 * MiB;
constexpr size_t WS_ROPE = 5 * MiB;
constexpr size_t WS_WSB = 6 * MiB;
constexpr size_t WS_SSQ = 7 * MiB;
constexpr size_t WS_WABIN = 12 * MiB;
constexpr size_t WS_WABOUT = 24 * MiB;
constexpr size_t WS_WCMIN = 28 * MiB;
constexpr size_t WS_WCMOUT = 36 * MiB;
constexpr size_t WS_WFF1 = 40 * MiB;
constexpr size_t WS_WFF2 = 72 * MiB;
constexpr size_t WS_XCTX = 104 * MiB;
constexpr size_t WS_XN = 136 * MiB;
constexpr size_t WS_BIG = 280 * MiB;
constexpr size_t WS_ST = WS_BIG + 432 * MiB;
constexpr size_t WS_END = 856 * MiB;
constexpr int LDS_BYTES = 147456;

__device__ __forceinline__ float bf2f(bf16_t v) { return __uint_as_float((unsigned)v << 16); }
__device__ __forceinline__ unsigned f2bf(float f) { unsigned u = __float_as_uint(f); return (u + 0x7fffu + ((u >> 16) & 1u)) >> 16; }
__device__ __forceinline__ unsigned cvtpk(float lo, float hi) { unsigned r; asm volatile("v_cvt_pk_bf16_f32 %0, %1, %2" : "=v"(r) : "v"(lo), "v"(hi)); return r; }
__device__ __forceinline__ float wave_sum(float v) {
#pragma unroll
    for (int o = 1; o < 64; o <<= 1) v += __shfl_xor(v, o);
    return v;
}
#define LDS_WAIT() asm volatile("s_waitcnt lgkmcnt(0)" ::: "memory")
#define SBAR() __builtin_amdgcn_sched_barrier(0)
#define KSWZ(row, colB) ((row) * 256 + ((colB) ^ (((row) & 7) << 4)))
__device__ __forceinline__ int crow(int r, int hi) { return (r & 3) + 8 * (r >> 2) + 4 * hi; }

__device__ __forceinline__ int v_st(int k, int c) { const int kk = (k & ~0xC) | ((k & 4) << 1) | ((k & 8) >> 1); return ((kk >> 3) * 4 + (c >> 5)) * 512 + ((kk & 7) * 32 + (c & 31)) * 2; }
__device__ __forceinline__ int v_rd_base(int lane) { return ((lane & 3) << 3) | (((lane >> 2) & 3) << 6) | (((lane >> 4) & 1) << 5) | (((lane >> 5) & 1) << 8); }
constexpr int v_rd_off(int d0, int ks, int half) { return d0 * 512 + ks * 4096 + half * 2048; }
template <int OFF> __device__ __forceinline__ s16x4 tr_read(int vb) {
    s16x4 r; asm volatile("ds_read_b64_tr_b16 %0, %1 offset:%2" : "=&v"(r) : "v"(vb), "i"(OFF) : "memory"); return r;
}
#define PKLH(L, H) (bf16x8){L[0], L[1], L[2], L[3], H[0], H[1], H[2], H[3]}
template <int D0> __device__ __forceinline__ void pv_one(f32x16& od, int vb, bf16x8 pa0, bf16x8 pa1, bf16x8 pa2, bf16x8 pa3) {
    const s16x4 l0 = tr_read<v_rd_off(D0, 0, 0)>(vb), h0 = tr_read<v_rd_off(D0, 0, 1)>(vb), l1 = tr_read<v_rd_off(D0, 1, 0)>(vb), h1 = tr_read<v_rd_off(D0, 1, 1)>(vb);
    const s16x4 l2 = tr_read<v_rd_off(D0, 2, 0)>(vb), h2 = tr_read<v_rd_off(D0, 2, 1)>(vb), l3 = tr_read<v_rd_off(D0, 3, 0)>(vb), h3 = tr_read<v_rd_off(D0, 3, 1)>(vb);
    asm volatile("s_waitcnt lgkmcnt(0)" ::: "memory"); SBAR();
    od = __builtin_amdgcn_mfma_f32_32x32x16_bf16(pa0, PKLH(l0, h0), od, 0, 0, 0);
    od = __builtin_amdgcn_mfma_f32_32x32x16_bf16(pa1, PKLH(l1, h1), od, 0, 0, 0);
    od = __builtin_amdgcn_mfma_f32_32x32x16_bf16(pa2, PKLH(l2, h2), od, 0, 0, 0);
    od = __builtin_amdgcn_mfma_f32_32x32x16_bf16(pa3, PKLH(l3, h3), od, 0, 0, 0);
}
__device__ __forceinline__ void pv_d0(f32x16* o, int vb, bf16x8 pa0, bf16x8 pa1, bf16x8 pa2, bf16x8 pa3) {
    pv_one<0>(o[0], vb, pa0, pa1, pa2, pa3); pv_one<1>(o[1], vb, pa0, pa1, pa2, pa3); pv_one<2>(o[2], vb, pa0, pa1, pa2, pa3); pv_one<3>(o[3], vb, pa0, pa1, pa2, pa3);
}
__device__ __forceinline__ void pack_p(const f32x16& p0, const f32x16& p1, bf16x8& pa0, bf16x8& pa1, bf16x8& pa2, bf16x8& pa3) {
#define PK4(P, BASE, OUT) do { unsigned a0 = cvtpk(P[BASE + 0], P[BASE + 1]), a1 = cvtpk(P[BASE + 2], P[BASE + 3]);   \
    unsigned b0 = cvtpk(P[BASE + 4], P[BASE + 5]), b1 = cvtpk(P[BASE + 6], P[BASE + 7]);                              \
    auto r0 = __builtin_amdgcn_permlane32_swap(a0, b0, false, false); auto r1 = __builtin_amdgcn_permlane32_swap(a1, b1, false, false); \
    u32x4 w = {r0[0], r1[0], r0[1], r1[1]}; OUT = *reinterpret_cast<bf16x8*>(&w); } while (0)
    PK4(p0, 0, pa0); PK4(p0, 8, pa1); PK4(p1, 0, pa2); PK4(p1, 8, pa3);
#undef PK4
}
__device__ __forceinline__ void qkt(f32x16& p0, f32x16& p1, const char* Ks, const bf16x8* qr, int r32, int hi) {
    p0 = f32x16{}; p1 = f32x16{};
#pragma unroll
    for (int d0 = 0; d0 < 8; ++d0) { int cb = (d0 * 16 + hi * 8) * 2;
        bf16x8 b0 = *reinterpret_cast<const bf16x8*>(Ks + KSWZ(r32, cb));
        bf16x8 b1 = *reinterpret_cast<const bf16x8*>(Ks + KSWZ(32 + r32, cb));
        p0 = __builtin_amdgcn_mfma_f32_32x32x16_bf16(b0, qr[d0], p0, 0, 0, 0);
        p1 = __builtin_amdgcn_mfma_f32_32x32x16_bf16(b1, qr[d0], p1, 0, 0, 0); }
}

namespace attn {
constexpr int D = 128, NW = 8, QBLK = 32, KVBLK = 64;
constexpr float SCALE = 0.088388347648318440f, THR = 8.f;
constexpr int LDQ = NIN, LDK = NIN, LDO = DM;
constexpr size_t SHM_V = KVBLK * D * 2, SHM_K = KVBLK * D * 2;
__device__ __forceinline__ void partialSM(f32x16& p0, f32x16& p1, float& m_reg, float& mn, float& alpha) {
    constexpr float C = SCALE * 1.4426950408889634f;
    float pmax = p0[0];
#pragma unroll
    for (int r = 1; r < 16; ++r) pmax = fmaxf(pmax, p0[r]);
#pragma unroll
    for (int r = 0; r < 16; ++r) pmax = fmaxf(pmax, p1[r]);
    { auto rr = __builtin_amdgcn_permlane32_swap(__float_as_uint(pmax), __float_as_uint(pmax), false, false);
      pmax = fmaxf(__uint_as_float(rr[0]), __uint_as_float(rr[1])); }
    if (__builtin_expect(__all(pmax - m_reg <= THR / SCALE), 1)) { mn = m_reg; alpha = 1.f; }
    else { mn = fmaxf(m_reg, pmax); alpha = __builtin_amdgcn_exp2f((m_reg - mn) * C); m_reg = mn; }
    float mnC = -mn * C;
#pragma unroll
    for (int r = 0; r < 16; ++r) p0[r] = fmaf(p0[r], C, mnC);
#pragma unroll
    for (int r = 0; r < 16; ++r) p1[r] = fmaf(p1[r], C, mnC);
#pragma unroll
    for (int r = 0; r < 16; ++r) p0[r] = __builtin_amdgcn_exp2f(p0[r]);
}
__device__ __forceinline__ void finishSM(f32x16& p0, f32x16& p1, float alpha, float& l_reg, bf16x8& pa0, bf16x8& pa1, bf16x8& pa2, bf16x8& pa3) {
#pragma unroll
    for (int r = 0; r < 16; ++r) p1[r] = __builtin_amdgcn_exp2f(p1[r]);
    float ps = 0;
#pragma unroll
    for (int r = 0; r < 16; ++r) ps += p0[r];
#pragma unroll
    for (int r = 0; r < 16; ++r) ps += p1[r];
    { auto rr = __builtin_amdgcn_permlane32_swap(__float_as_uint(ps), __float_as_uint(ps), false, false);
      ps = __uint_as_float(rr[0]) + __uint_as_float(rr[1]); }
    l_reg = l_reg * alpha + ps;
    pack_p(p0, p1, pa0, pa1, pa2, pa3);
}
__device__ __forceinline__ void body(const bf16_t* __restrict__ Qb, const bf16_t* __restrict__ Kc, const bf16_t* __restrict__ Vc, int nctx,
                                     const bf16_t* __restrict__ Kl, const bf16_t* __restrict__ Vl, bf16_t* __restrict__ Ob, int seq, char* lds) {
    int tid_ = threadIdx.x; asm volatile("" : "+v"(tid_)); const int tid = tid_, wid = tid >> 6, lane = tid & 63, r32 = lane & 31, hi = lane >> 5;
    char* V_lds = lds; char* K_lds = lds + 2 * SHM_V;
    float* wsp = (float*)(lds + 2 * SHM_V + 2 * SHM_K) + wid * 64; float* li_l = wsp; float* al_l = wsp + 32;
    float m_reg = -1e30f, l_reg = 0; f32x16 o[4] = {}; bf16x8 qr[8];
    const bf16_t* Qw = Qb + (long)(wid * QBLK + r32) * LDQ + hi * 8;
#pragma unroll
    for (int d0 = 0; d0 < 8; ++d0) qr[d0] = *reinterpret_cast<const bf16x8*>(Qw + d0 * 16);
    const int sr = tid >> 4, sc = (tid & 15) * 8, vst0 = v_st(sr, sc), vst1 = v_st(32 + sr, sc);
    const int vb0 = (int)(uintptr_t)V_lds + v_rd_base(lane);
    struct { bf16x8 vs0, vs1, ks0, ks1; } sr_[2];
#define SLOAD(i, k0) do { const int _k = (k0); const bf16_t* _kp = (_k < nctx) ? Kc + (long)_k * LDK : Kl + (long)(_k - nctx) * LDK; const bf16_t* _vp = (_k < nctx) ? Vc + (long)_k * LDK : Vl + (long)(_k - nctx) * LDK; \
    sr_[i].vs0 = *reinterpret_cast<const bf16x8*>(&_vp[(long)sr * LDK + sc]); sr_[i].vs1 = *reinterpret_cast<const bf16x8*>(&_vp[(long)(32 + sr) * LDK + sc]); \
    sr_[i].ks0 = *reinterpret_cast<const bf16x8*>(&_kp[(long)sr * LDK + sc]); sr_[i].ks1 = *reinterpret_cast<const bf16x8*>(&_kp[(long)(32 + sr) * LDK + sc]); } while (0)
#define SWRITE(b, i) do { *(bf16x8*)(V_lds + (b) * SHM_V + vst0) = sr_[i].vs0;          \
    *(bf16x8*)(V_lds + (b) * SHM_V + vst1) = sr_[i].vs1; int kc = sc * 2;               \
    *(bf16x8*)(K_lds + (b) * SHM_K + KSWZ(sr, kc)) = sr_[i].ks0;                       \
    *(bf16x8*)(K_lds + (b) * SHM_K + KSWZ(32 + sr, kc)) = sr_[i].ks1; } while (0)
#define SWAIT() asm volatile("s_waitcnt vmcnt(4)" ::: "memory")
#define RESC(a) do { if (__any((a) < 1.f)) { if (hi == 0) al_l[r32] = (a); asm volatile("s_waitcnt lgkmcnt(0)" ::: "memory"); \
    _Pragma("unroll") for (int d = 0; d < 4; ++d) _Pragma("unroll") for (int r = 0; r < 16; ++r) o[d][r] *= al_l[crow(r, hi)]; } } while (0)
    f32x16 pA0, pA1, pB0, pB1; float mnA, mnB, alA, alB; bf16x8 pa0, pa1, pa2, pa3; const int NT = seq / KVBLK;
    constexpr int SE = 0, SO = 1;
    SLOAD(SE, 0); asm volatile("s_waitcnt vmcnt(0)" ::: "memory"); SWRITE(0, SE); __syncthreads();
    qkt(pA0, pA1, K_lds, qr, r32, hi); partialSM(pA0, pA1, m_reg, mnA, alA);
    SLOAD(SO, KVBLK); if (2 < NT) SLOAD(SE, 2 * KVBLK);
    SWAIT(); SWRITE(1, SO); __syncthreads();
    for (int j = 1; j + 1 < NT; j += 2) {
        SBAR(); qkt(pB0, pB1, K_lds + SHM_K, qr, r32, hi);
        finishSM(pA0, pA1, alA, l_reg, pa0, pa1, pa2, pa3); SBAR();
        SLOAD(SO, (j + 2) * KVBLK); SBAR();
        pv_d0(o, vb0, pa0, pa1, pa2, pa3); partialSM(pB0, pB1, m_reg, mnB, alB);
        __syncthreads(); SWAIT(); SWRITE(0, SE);
        RESC(alB); __syncthreads();
        SBAR(); qkt(pA0, pA1, K_lds, qr, r32, hi);
        finishSM(pB0, pB1, alB, l_reg, pa0, pa1, pa2, pa3); SBAR();
        if (j + 3 < NT) SLOAD(SE, (j + 3) * KVBLK); SBAR();
        pv_d0(o, vb0 + (int)SHM_V, pa0, pa1, pa2, pa3); partialSM(pA0, pA1, m_reg, mnA, alA);
        __syncthreads(); SWAIT(); SWRITE(1, SO);
        RESC(alA); __syncthreads();
    }
    SBAR(); qkt(pB0, pB1, K_lds + SHM_K, qr, r32, hi);
    finishSM(pA0, pA1, alA, l_reg, pa0, pa1, pa2, pa3); SBAR();
    pv_d0(o, vb0, pa0, pa1, pa2, pa3); partialSM(pB0, pB1, m_reg, mnB, alB);
    __syncthreads(); RESC(alB);
    finishSM(pB0, pB1, alB, l_reg, pa0, pa1, pa2, pa3); SBAR();
    pv_d0(o, vb0 + (int)SHM_V, pa0, pa1, pa2, pa3);
    if (hi == 0) li_l[r32] = l_reg; asm volatile("s_waitcnt lgkmcnt(0)" ::: "memory");
    float rli[16];
#pragma unroll
    for (int r = 0; r < 16; ++r) rli[r] = __builtin_amdgcn_rcpf(li_l[crow(r, hi)]);
    bf16_t* Ow = Ob + (long)(wid * QBLK) * LDO;
#pragma unroll
    for (int r = 0; r < 16; ++r) { int orow = crow(r, hi);
#pragma unroll
        for (int d0 = 0; d0 < 4; ++d0) Ow[(long)orow * LDO + d0 * 32 + r32] = (bf16_t)f2bf(o[d0][r] * rli[r]); }
#undef SLOAD
#undef SWRITE
#undef SWAIT
#undef RESC
}
}

struct Args {
    const float* x; const float* c; const float* ctx; const float* c_ctx; const float* mod_w; const float* mod_b;
    const float* norm1_g; const float* norm2_g; const float* ab_w_in; const float* ab_w_out; const float* ret_decay;
    const float* q_g; const float* k_g; const float* cm_w_in; const float* cm_v_g; const float* cm_w_s; const float* cm_b_s;
    const float* cm_w_out; const float* ff_w1; const float* ff_w2;
    float* out; unsigned char* ws; int ph_lo, ph_hi;
};

__device__ __forceinline__ void transpose_item(const float* W, int K, int N, bf16_t* WT, float* scr, int item, int lane) {
    const int nblk = N / 32, kb = item / nblk, nb = item % nblk, k0 = 64 * kb, n0 = 32 * nb;
#pragma unroll 8
    for (int i = 0; i < 32; ++i) { const int kk = 2 * i + (lane >> 5); scr[kk * 33 + (lane & 31)] = W[(size_t)(k0 + kk) * N + n0 + (lane & 31)]; }
    LDS_WAIT(); asm volatile("" ::: "memory");
    const int c = lane & 7;
#pragma unroll
    for (int j = 0; j < 4; ++j) { const int n = (lane >> 3) + 8 * j; const float* s = scr + (8 * c) * 33 + n;
        u32x4 o; o.x = cvtpk(s[0 * 33], s[1 * 33]); o.y = cvtpk(s[2 * 33], s[3 * 33]); o.z = cvtpk(s[4 * 33], s[5 * 33]); o.w = cvtpk(s[6 * 33], s[7 * 33]);
        *(u32x4*)(WT + (size_t)(n0 + n) * K + k0 + 8 * c) = o; }
    LDS_WAIT(); asm volatile("" ::: "memory");
}

__device__ __forceinline__ void prologue(const Args& a, char* lds, int G) {
    int tid_ = threadIdx.x; asm volatile("" : "+v"(tid_)); const int tid = tid_, lane = tid & 63, wave = tid >> 6;
    const int gw = blockIdx.x * 8 + wave, NGW = G * 8;
    unsigned char* ws = a.ws;
    float* scr = (float*)(lds + wave * 16384);
    constexpr int I_ABIN = 16 * 96, I_SQ = 16 * 32, I_CMIN = 16 * 64, I_FF = 16 * 128;
    constexpr int NITEMS = 2 * I_ABIN + 2 * I_SQ + 2 * I_CMIN + 2 * I_SQ + 4 * I_FF + 4 * I_FF;
    for (int it = gw; it < NITEMS; it += NGW) {
        int r = it;
        if (r < 2 * I_ABIN) { const int i = r / I_ABIN; transpose_item(a.ab_w_in + (size_t)i * 1024 * 3072, 1024, 3072, (bf16_t*)(ws + WS_WABIN) + (size_t)i * 3072 * 1024, scr, r % I_ABIN, lane); continue; } r -= 2 * I_ABIN;
        if (r < 2 * I_SQ) { const int i = r / I_SQ; transpose_item(a.ab_w_out + (size_t)i * 1024 * 1024, 1024, 1024, (bf16_t*)(ws + WS_WABOUT) + (size_t)i * 1024 * 1024, scr, r % I_SQ, lane); continue; } r -= 2 * I_SQ;
        if (r < 2 * I_CMIN) { const int i = r / I_CMIN; transpose_item(a.cm_w_in + (size_t)i * 1024 * 2048, 1024, 2048, (bf16_t*)(ws + WS_WCMIN) + (size_t)i * 2048 * 1024, scr, r % I_CMIN, lane); continue; } r -= 2 * I_CMIN;
        if (r < 2 * I_SQ) { const int i = r / I_SQ; transpose_item(a.cm_w_out + (size_t)i * 1024 * 1024, 1024, 1024, (bf16_t*)(ws + WS_WCMOUT) + (size_t)i * 1024 * 1024, scr, r % I_SQ, lane); continue; } r -= 2 * I_SQ;
        if (r < 4 * I_FF) { const int i = r / I_FF; transpose_item(a.ff_w1 + (size_t)i * 1024 * 4096, 1024, 4096, (bf16_t*)(ws + WS_WFF1) + (size_t)i * 4096 * 1024, scr, r % I_FF, lane); continue; } r -= 4 * I_FF;
        { const int i = r / I_FF; transpose_item(a.ff_w2 + (size_t)i * 4096 * 1024, 4096, 1024, (bf16_t*)(ws + WS_WFF2) + (size_t)i * 1024 * 4096, scr, r % I_FF, lane); }
    }
    { bf16_t* wsb = (bf16_t*)(ws + WS_WSB);
      for (int i = blockIdx.x * 512 + tid; i < 2 * 8 * 128 * 128 / 2; i += G * 512) { const float2 v = ((const float2*)a.cm_w_s)[i]; ((unsigned*)wsb)[i] = cvtpk(v.x, v.y); } }
    { float* rc = (float*)(ws + WS_ROPE); float* rs = rc + 2048 * 64;
      for (int i = blockIdx.x * 512 + tid; i < 2048 * 64; i += G * 512) { const int t = i >> 6, j = i & 63; const int f = j & 31;
          const float inv = exp2f(-(float)f * (13.287712379549449f / 32.0f));
          const float pos = (j < 32) ? (float)(t >> 6) : (float)(t & 63);
          const float ang = pos * inv; rc[i] = cosf(ang); rs[i] = sinf(ang); } }
    __syncthreads();
    float* T = (float*)lds;
    float* red = (float*)(lds + 81920);
    float* MOD = (float*)(ws + WS_MOD);
#pragma unroll 1
    for (int pass = 0; pass < 2; ++pass) {
        const int j0 = pass * 17;
        for (int e = tid; e < 17 * 1024; e += 512) { const int jj = e >> 10, k = e & 1023, j = j0 + jj; float v = 0.f;
            if (j < 33) { const float cv = (j < 32) ? a.c[j * 1024 + k] : a.c_ctx[k]; v = cv / (1.0f + __expf(-cv)); }
            T[k * 20 + jj] = v; }
        __syncthreads();
        for (int item = blockIdx.x; item < 4 * 96; item += G) {
            const int l = item / 96, n0 = (item % 96) * 64;
            float acc[17];
#pragma unroll
            for (int jj = 0; jj < 17; ++jj) acc[jj] = 0.f;
            const float* wp = a.mod_w + ((size_t)l * 1024 + wave * 128) * 6144 + n0 + lane;
#pragma unroll 4
            for (int kk = 0; kk < 128; ++kk) { const float wv = wp[(size_t)kk * 6144]; const float* tp = T + (wave * 128 + kk) * 20;
                const f32x4 t0 = *(const f32x4*)(tp), t1 = *(const f32x4*)(tp + 4), t2 = *(const f32x4*)(tp + 8), t3 = *(const f32x4*)(tp + 12); const float t16 = tp[16];
                acc[0] += t0[0] * wv; acc[1] += t0[1] * wv; acc[2] += t0[2] * wv; acc[3] += t0[3] * wv;
                acc[4] += t1[0] * wv; acc[5] += t1[1] * wv; acc[6] += t1[2] * wv; acc[7] += t1[3] * wv;
                acc[8] += t2[0] * wv; acc[9] += t2[1] * wv; acc[10] += t2[2] * wv; acc[11] += t2[3] * wv;
                acc[12] += t3[0] * wv; acc[13] += t3[1] * wv; acc[14] += t3[2] * wv; acc[15] += t3[3] * wv; acc[16] += t16 * wv; }
#pragma unroll
            for (int jj = 0; jj < 17; ++jj) red[(jj * 8 + wave) * 64 + lane] = acc[jj];
            __syncthreads();
            for (int e = tid; e < 17 * 64; e += 512) { const int jj = e >> 6, ln = e & 63, j = j0 + jj; float s = 0.f;
#pragma unroll
                for (int w = 0; w < 8; ++w) s += red[(jj * 8 + w) * 64 + ln];
                if (j < 33) MOD[((size_t)l * 33 + j) * 6144 + n0 + ln] = s + a.mod_b[l * 6144 + n0 + ln]; }
            __syncthreads();
        }
        __syncthreads();
    }
}

__device__ __forceinline__ void norm_phase(const float* xlat, const float* xctx, const float* g, const float* modl, int which, bf16_t* XN, int Mrows, int ngw) {
    int tid_ = threadIdx.x; asm volatile("" : "+v"(tid_)); const int lane = tid_ & 63, gw = blockIdx.x * 8 + (tid_ >> 6);
    for (int r = gw; r < Mrows; r += ngw) {
        const float* src = r < RLAT ? xlat + (size_t)r * 1024 : xctx + (size_t)(r - RLAT) * 1024;
        const int bidx = r < RLAT ? (r >> 11) : 32;
        const float* mp = modl + (size_t)bidx * 6144 + which * 3072;
        f32x4 v[4]; float s = 0.f;
#pragma unroll
        for (int j = 0; j < 4; ++j) { v[j] = ((const f32x4*)src)[lane + 64 * j]; s += (v[j][0] * v[j][0] + v[j][1] * v[j][1]) + (v[j][2] * v[j][2] + v[j][3] * v[j][3]); }
        const float rinv = rsqrtf(wave_sum(s) * (1.0f / 1024.0f) + EPS);
        u32x2* o8 = (u32x2*)(XN + (size_t)r * 1024);
#pragma unroll
        for (int j = 0; j < 4; ++j) { const int c4 = lane + 64 * j; const f32x4 gv = ((const f32x4*)g)[c4], sh = ((const f32x4*)mp)[c4], sc = ((const f32x4*)(mp + 1024))[c4];
            const f32x4 y = (v[j] * rinv * gv) * (sc + 1.0f) + sh; u32x2 w; w.x = cvtpk(y[0], y[1]); w.y = cvtpk(y[2], y[3]); o8[c4] = w; }
    }
}

__device__ __forceinline__ void ropenorm_phase(bf16_t* P, const float* ropec, const float* ropes, const float* qg, const float* kg, int ngw) {
    int tid_ = threadIdx.x; asm volatile("" : "+v"(tid_)); const int lane = tid_ & 63, gw = blockIdx.x * 8 + (tid_ >> 6);
    const float qg1 = qg[lane], qg2 = qg[64 + lane], kg1 = kg[lane], kg2 = kg[64 + lane];
    for (int r = gw; r < RTOT; r += ngw) {
        bf16_t* prow = P + (size_t)r * NIN; const bool lat = r < RLAT; float cs = 1.f, sn = 0.f;
        if (lat) { const int t = r & 2047; cs = ropec[t * 64 + lane]; sn = ropes[t * 64 + lane]; }
        if (lat) {
#pragma unroll
            for (int h = 0; h < 4; ++h) { bf16_t* p = prow + h * 128 + lane; const float x1 = bf2f(p[0]), x2 = bf2f(p[64]); p[0] = (bf16_t)f2bf(x1 * cs - x2 * sn); p[64] = (bf16_t)f2bf(x1 * sn + x2 * cs); }
        }
#pragma unroll
        for (int h = 0; h < 4; ++h) { bf16_t* p = prow + 512 + h * 128 + lane; const float x1 = bf2f(p[0]) * 0.088388347648318440f, x2 = bf2f(p[64]) * 0.088388347648318440f;
            p[0] = (bf16_t)f2bf(x1 * cs - x2 * sn); p[64] = (bf16_t)f2bf(x1 * sn + x2 * cs); }
#pragma unroll
        for (int h = 0; h < 4; ++h) { bf16_t* p = prow + 2048 + h * 128 + lane; float x1 = bf2f(p[0]), x2 = bf2f(p[64]);
            const float rinv = rsqrtf(wave_sum(x1 * x1 + x2 * x2) * (1.0f / 128.0f) + EPS); x1 *= rinv * qg1; x2 *= rinv * qg2;
            p[0] = (bf16_t)f2bf(x1 * cs - x2 * sn); p[64] = (bf16_t)f2bf(x1 * sn + x2 * cs); }
#pragma unroll
        for (int h = 0; h < 2; ++h) { bf16_t* p = prow + 2560 + h * 128 + lane; float x1 = bf2f(p[0]), x2 = bf2f(p[64]);
            const float rinv = rsqrtf(wave_sum(x1 * x1 + x2 * x2) * (1.0f / 128.0f) + EPS); x1 *= rinv * kg1; x2 *= rinv * kg2;
            p[0] = (bf16_t)f2bf(x1 * cs - x2 * sn); p[64] = (bf16_t)f2bf(x1 * sn + x2 * cs); }
    }
}

__device__ __forceinline__ int chunk_rowbase(int b, int cid) { return cid < 2 ? RLAT + b * 256 + cid * 128 : b * 2048 + (cid - 2) * 128; }

__device__ __forceinline__ void ret_state_unit(const bf16_t* P, bf16_t* ST, int b, int h, int dir, float lg2, char* lds) {
    int tid_ = threadIdx.x; asm volatile("" : "+v"(tid_)); const int tid = tid_, wid = tid >> 6, lane = tid & 63, r32 = lane & 31, hi = lane >> 5;
    const int db = wid & 3, eh = wid >> 2;
    const int sr = tid >> 4, sc = (tid & 15) * 8;
    char* Kt = lds; char* Vt = lds + 32768;
    const int vbA = (int)(uintptr_t)Kt + v_rd_base(lane) + db * 512;
    const int vbB = (int)(uintptr_t)Vt + v_rd_base(lane) + eh * 1024;
    const float cd = exp2f(128.0f * lg2);
    f32x16 st[2] = {};
    bf16_t* STu = ST + (size_t)((b * 4 + h) * 2 + dir) * 18 * 16384;
#pragma unroll 1
    for (int s = 0; s < 18; ++s) {
        const int cid = dir == 0 ? s : (s == 0 ? 1 : (s == 1 ? 0 : 19 - s));
        bf16_t* Sp = STu + (size_t)cid * 16384;
#pragma unroll
        for (int t = 0; t < 2; ++t)
#pragma unroll
            for (int rg = 0; rg < 4; ++rg) { const int e = (2 * eh + t) * 32 + r32, d = db * 32 + 8 * rg + 4 * hi;
                u32x2 w; w.x = cvtpk(st[t][4 * rg + 0], st[t][4 * rg + 1]); w.y = cvtpk(st[t][4 * rg + 2], st[t][4 * rg + 3]); *(u32x2*)(Sp + e * 128 + d) = w; }
        if (s == 17) break;
        const int rowbase = chunk_rowbase(b, cid);
        __syncthreads();
#pragma unroll
        for (int q = 0; q < 4; ++q) { const int key = q * 32 + sr; const bf16_t* pr = P + (size_t)(rowbase + key) * NIN + h * 128 + sc;
            const bf16x8 kv = *reinterpret_cast<const bf16x8*>(pr + 512); const bf16x8 vv = *reinterpret_cast<const bf16x8*>(pr + 1024);
            const float kd = exp2f(lg2 * (float)(dir ? key : 127 - key));
            u32x4 w;
            w.x = cvtpk(bf2f((bf16_t)vv[0]) * kd, bf2f((bf16_t)vv[1]) * kd); w.y = cvtpk(bf2f((bf16_t)vv[2]) * kd, bf2f((bf16_t)vv[3]) * kd);
            w.z = cvtpk(bf2f((bf16_t)vv[4]) * kd, bf2f((bf16_t)vv[5]) * kd); w.w = cvtpk(bf2f((bf16_t)vv[6]) * kd, bf2f((bf16_t)vv[7]) * kd);
            const int off = (key >> 6) * 16384 + v_st(key & 63, sc);
            *(bf16x8*)(Kt + off) = kv; *(u32x4*)(Vt + off) = w; }
        __syncthreads();
        f32x16 acc[2] = {};
#pragma unroll
        for (int tile = 0; tile < 2; ++tile) {
#define RS_STEP(KS) do { const s16x4 al = tr_read<v_rd_off(0, KS, 0)>(vbA + tile * 16384), ah = tr_read<v_rd_off(0, KS, 1)>(vbA + tile * 16384); \
            const s16x4 b0l = tr_read<v_rd_off(0, KS, 0)>(vbB + tile * 16384), b0h = tr_read<v_rd_off(0, KS, 1)>(vbB + tile * 16384); \
            const s16x4 b1l = tr_read<v_rd_off(1, KS, 0)>(vbB + tile * 16384), b1h = tr_read<v_rd_off(1, KS, 1)>(vbB + tile * 16384); \
            asm volatile("s_waitcnt lgkmcnt(0)" ::: "memory"); SBAR(); \
            acc[0] = __builtin_amdgcn_mfma_f32_32x32x16_bf16(PKLH(al, ah), PKLH(b0l, b0h), acc[0], 0, 0, 0); \
            acc[1] = __builtin_amdgcn_mfma_f32_32x32x16_bf16(PKLH(al, ah), PKLH(b1l, b1h), acc[1], 0, 0, 0); } while (0)
            RS_STEP(0); RS_STEP(1); RS_STEP(2); RS_STEP(3);
#undef RS_STEP
        }
#pragma unroll
        for (int t = 0; t < 2; ++t)
#pragma unroll
            for (int r = 0; r < 16; ++r) st[t][r] = st[t][r] * cd + acc[t][r];
    }
    __syncthreads();
}

__device__ __forceinline__ void ret_out_unit(const bf16_t* P, const bf16_t* ST, bf16_t* O, int b, int h, int cid, float lgf, float lgb, char* lds) {
    int tid_ = threadIdx.x; asm volatile("" : "+v"(tid_)); const int tid = tid_, wid = tid >> 6, lane = tid & 63, r32 = lane & 31, hi = lane >> 5;
    const int rb = wid & 3, eh = wid >> 2;
    const int sr = tid >> 4, sc = (tid & 15) * 8;
    char* Kt = lds; char* Vt = lds + 32768; char* Sf = lds + 65536; char* Sb = lds + 98304;
    const int rowbase = chunk_rowbase(b, cid);
    const bf16_t* Sfg = ST + (size_t)(((b * 4 + h) * 2 + 0) * 18 + cid) * 16384;
    const bf16_t* Sbg = ST + (size_t)(((b * 4 + h) * 2 + 1) * 18 + cid) * 16384;
    __syncthreads();
#pragma unroll
    for (int q = 0; q < 4; ++q) { const int key = q * 32 + sr; const bf16_t* pr = P + (size_t)(rowbase + key) * NIN + h * 128 + sc;
        const bf16x8 kv = *reinterpret_cast<const bf16x8*>(pr + 512); const bf16x8 vv = *reinterpret_cast<const bf16x8*>(pr + 1024);
        const bf16x8 sf = *reinterpret_cast<const bf16x8*>(Sfg + key * 128 + sc); const bf16x8 sb = *reinterpret_cast<const bf16x8*>(Sbg + key * 128 + sc);
        *(bf16x8*)(Kt + (key >> 6) * 16384 + KSWZ(key & 63, sc * 2)) = kv;
        *(bf16x8*)(Vt + (key >> 6) * 16384 + v_st(key & 63, sc)) = vv;
        *(bf16x8*)(Sf + KSWZ(key, sc * 2)) = sf; *(bf16x8*)(Sb + KSWZ(key, sc * 2)) = sb; }
    bf16x8 qr[8];
    { const bf16_t* Qw = P + (size_t)(rowbase + rb * 32 + r32) * NIN + h * 128 + hi * 8;
#pragma unroll
      for (int d0 = 0; d0 < 8; ++d0) qr[d0] = *reinterpret_cast<const bf16x8*>(Qw + d0 * 16); }
    __syncthreads();
    f32x16 o[2] = {}, xf[2] = {}, xb[2] = {};
    const int irow = rb * 32 + r32;
    const int vb = (int)(uintptr_t)Vt + v_rd_base(lane) + eh * 1024;
#pragma unroll
    for (int jt = 0; jt < 2; ++jt) {
        f32x16 p0, p1; qkt(p0, p1, Kt + jt * 16384, qr, r32, hi);
#pragma unroll
        for (int r = 0; r < 16; ++r) { const int j0 = jt * 64 + crow(r, hi), d0 = irow - j0, d1 = d0 - 32;
            const float w0 = d0 > 0 ? exp2f(lgf * (float)d0) : (d0 < 0 ? exp2f(lgb * (float)(-d0)) : 2.0f);
            const float w1 = d1 > 0 ? exp2f(lgf * (float)d1) : (d1 < 0 ? exp2f(lgb * (float)(-d1)) : 2.0f);
            p0[r] *= w0; p1[r] *= w1; }
        bf16x8 pa0, pa1, pa2, pa3; pack_p(p0, p1, pa0, pa1, pa2, pa3);
        pv_one<0>(o[0], vb + jt * 16384, pa0, pa1, pa2, pa3); pv_one<1>(o[1], vb + jt * 16384, pa0, pa1, pa2, pa3);
    }
#pragma unroll
    for (int t = 0; t < 2; ++t)
#pragma unroll
        for (int d0 = 0; d0 < 8; ++d0) { const int e = (2 * eh + t) * 32 + r32, cb = (d0 * 16 + hi * 8) * 2;
            const bf16x8 bf = *reinterpret_cast<const bf16x8*>(Sf + KSWZ(e, cb)); const bf16x8 bb = *reinterpret_cast<const bf16x8*>(Sb + KSWZ(e, cb));
            xf[t] = __builtin_amdgcn_mfma_f32_32x32x16_bf16(qr[d0], bf, xf[t], 0, 0, 0);
            xb[t] = __builtin_amdgcn_mfma_f32_32x32x16_bf16(qr[d0], bb, xb[t], 0, 0, 0); }
    __syncthreads();
    float* OT = (float*)lds;
#pragma unroll
    for (int r = 0; r < 16; ++r) { const int i = rb * 32 + crow(r, hi); const float wf = exp2f(lgf * (float)(i + 1)), wb = exp2f(lgb * (float)(128 - i));
#pragma unroll
        for (int t = 0; t < 2; ++t) OT[i * 132 + (2 * eh + t) * 32 + r32] = o[t][r] + wf * xf[t][r] + wb * xb[t][r]; }
    __syncthreads();
    { const int row = tid >> 2, qd = tid & 3; const float* op = OT + row * 132 + qd * 32; f32x4 v[8]; float s = 0.f;
#pragma unroll
      for (int j = 0; j < 8; ++j) { v[j] = *(const f32x4*)(op + 4 * j); s += (v[j][0] + v[j][1]) + (v[j][2] + v[j][3]); }
      s += __shfl_xor(s, 1); s += __shfl_xor(s, 2); const float mu = s * (1.0f / 128.0f); float q = 0.f;
#pragma unroll
      for (int j = 0; j < 8; ++j) { v[j] = v[j] - mu; q += (v[j][0] * v[j][0] + v[j][1] * v[j][1]) + (v[j][2] * v[j][2] + v[j][3] * v[j][3]); }
      q += __shfl_xor(q, 1); q += __shfl_xor(q, 2); const float rstd = rsqrtf(q * (1.0f / 128.0f) + EPS);
      const bf16_t* gp = P + (size_t)(rowbase + row) * NIN + 1536 + h * 128 + qd * 32; bf16_t* od = O + (size_t)(rowbase + row) * DM + h * 128 + qd * 32;
#pragma unroll
      for (int j = 0; j < 4; ++j) { const bf16x8 gv = *reinterpret_cast<const bf16x8*>(gp + 8 * j); float y[8];
#pragma unroll
          for (int e = 0; e < 8; ++e) { const float g = bf2f((bf16_t)gv[e]); const float sg = g / (1.0f + __expf(-g)); y[e] = v[2 * j + (e >> 2)][e & 3] * rstd * sg; }
          u32x4 w; w.x = cvtpk(y[0], y[1]); w.y = cvtpk(y[2], y[3]); w.z = cvtpk(y[4], y[5]); w.w = cvtpk(y[6], y[7]); *(u32x4*)(od + 8 * j) = w; } }
}

__device__ __forceinline__ void gate_unit(const bf16_t* Z, const float* ssq, const float* vg, const bf16_t* wsb, const float* bs, bf16_t* Gout, int chunk, int g, char* lds) {
    int tid_ = threadIdx.x; asm volatile("" : "+v"(tid_)); const int tid = tid_, wid = tid >> 6, lane = tid & 63, r32 = lane & 31, hi = lane >> 5;
    const int pb = wid & 3, dh = wid >> 2;
    const int sr = tid >> 4, sc = (tid & 15) * 8;
    const int rowbase = chunk * 128;
    char* Vt = lds;
    bf16x8 af[8];
    { const bf16_t* wp = wsb + (size_t)(g * 128 + pb * 32 + r32) * 128 + hi * 8;
#pragma unroll
      for (int k8 = 0; k8 < 8; ++k8) af[k8] = *reinterpret_cast<const bf16x8*>(wp + k8 * 16); }
    const f32x4 g0 = *(const f32x4*)(vg + g * 128 + sc), g1 = *(const f32x4*)(vg + g * 128 + sc + 4);
    __syncthreads();
#pragma unroll
    for (int q = 0; q < 4; ++q) { const int key = q * 32 + sr; const int row = rowbase + key;
        const bf16x8 vv = *reinterpret_cast<const bf16x8*>(Z + (size_t)row * 2048 + 1024 + g * 128 + sc);
        const f32x4 s0 = *(const f32x4*)(ssq + (size_t)row * 16), s1 = *(const f32x4*)(ssq + (size_t)row * 16 + 4), s2 = *(const f32x4*)(ssq + (size_t)row * 16 + 8), s3 = *(const f32x4*)(ssq + (size_t)row * 16 + 12);
        const float tot = ((s0[0] + s0[1]) + (s0[2] + s0[3])) + ((s1[0] + s1[1]) + (s1[2] + s1[3])) + ((s2[0] + s2[1]) + (s2[2] + s2[3])) + ((s3[0] + s3[1]) + (s3[2] + s3[3]));
        const float rinv = rsqrtf(tot * (1.0f / 1024.0f) + EPS);
        u32x4 w;
        w.x = cvtpk(bf2f((bf16_t)vv[0]) * rinv * g0[0], bf2f((bf16_t)vv[1]) * rinv * g0[1]); w.y = cvtpk(bf2f((bf16_t)vv[2]) * rinv * g0[2], bf2f((bf16_t)vv[3]) * rinv * g0[3]);
        w.z = cvtpk(bf2f((bf16_t)vv[4]) * rinv * g1[0], bf2f((bf16_t)vv[5]) * rinv * g1[1]); w.w = cvtpk(bf2f((bf16_t)vv[6]) * rinv * g1[2], bf2f((bf16_t)vv[7]) * rinv * g1[3]);
        *(u32x4*)(Vt + (key >> 6) * 16384 + v_st(key & 63, sc)) = w; }
    __syncthreads();
    f32x16 acc[2] = {};
    const int vb = (int)(uintptr_t)Vt + v_rd_base(lane) + dh * 1024;
#pragma unroll
    for (int tile = 0; tile < 2; ++tile) {
#define GT_STEP(KS) do { const s16x4 b0l = tr_read<v_rd_off(0, KS, 0)>(vb + tile * 16384), b0h = tr_read<v_rd_off(0, KS, 1)>(vb + tile * 16384); \
        const s16x4 b1l = tr_read<v_rd_off(1, KS, 0)>(vb + tile * 16384), b1h = tr_read<v_rd_off(1, KS, 1)>(vb + tile * 16384); \
        asm volatile("s_waitcnt lgkmcnt(0)" ::: "memory"); SBAR(); \
        acc[0] = __builtin_amdgcn_mfma_f32_32x32x16_bf16(af[tile * 4 + KS], PKLH(b0l, b0h), acc[0], 0, 0, 0); \
        acc[1] = __builtin_amdgcn_mfma_f32_32x32x16_bf16(af[tile * 4 + KS], PKLH(b1l, b1h), acc[1], 0, 0, 0); } while (0)
        GT_STEP(0); GT_STEP(1); GT_STEP(2); GT_STEP(3);
#undef GT_STEP
    }
#pragma unroll
    for (int r = 0; r < 16; ++r) { const int p = pb * 32 + crow(r, hi); const float bias = bs[g * 128 + p];
        const bf16_t* up = Z + (size_t)(rowbase + p) * 2048 + g * 128; bf16_t* gp = Gout + (size_t)(rowbase + p) * DM + g * 128;
#pragma unroll
        for (int t = 0; t < 2; ++t) { const int d = (2 * dh + t) * 32 + r32; gp[d] = (bf16_t)f2bf(bf2f(up[d]) * (acc[t][r] + bias)); } }
}


#ifdef NO_ATT
#define PH_ATT(...) do {} while (0)
#else
#define PH_ATT(...) __VA_ARGS__
#endif
#ifdef NO_RS
#define PH_RS(...) do {} while (0)
#else
#define PH_RS(...) __VA_ARGS__
#endif
#ifdef NO_RO
#define PH_RO(...) do {} while (0)
#else
#define PH_RO(...) __VA_ARGS__
#endif
#ifdef NO_GT
#define PH_GT(...) do {} while (0)
#else
#define PH_GT(...) __VA_ARGS__
#endif
#ifdef NO_PRO
#define PH_PRO(...) do {} while (0)
#else
#define PH_PRO(...) __VA_ARGS__
#endif
#ifdef NO_GEMM
#define PH_GEMM(...) do {} while (0)
#else
#define PH_GEMM(...) __VA_ARGS__
#endif
__global__ void __launch_bounds__(512, 2) mk_fwd(Args a) {
    extern __shared__ __attribute__((aligned(16))) unsigned char lds_raw[];
    cg::grid_group grid = cg::this_grid();
    char* lds = (char*)lds_raw;
    int tid_ = threadIdx.x; asm volatile("" : "+v"(tid_)); const int tid = tid_, lane = tid & 63, wave = __builtin_amdgcn_readfirstlane(tid >> 6);
    const int G = gridDim.x, bx = blockIdx.x;
    const int gw = bx * 8 + wave, NGW = G * 8;
    unsigned char* ws = a.ws;
    float* MOD = (float*)(ws + WS_MOD);
    const float* ropec = (const float*)(ws + WS_ROPE); const float* ropes = ropec + 2048 * 64;
    bf16_t* XN = (bf16_t*)(ws + WS_XN); bf16_t* BIG = (bf16_t*)(ws + WS_BIG); bf16_t* ST = (bf16_t*)(ws + WS_ST);
    float* XCTX = (float*)(ws + WS_XCTX); float* SSQ = (float*)(ws + WS_SSQ);
    PG8_LAS unsigned char* glds = (PG8_LAS unsigned char*)lds_raw;

    PH_PRO(prologue(a, lds, G));
    grid.sync();

#pragma unroll 1
    for (int l = 0; l < DEPTH; ++l) {
        const bool even = (l & 1) == 0; const int li = l >> 1;
        const int Mrows = (l == DEPTH - 1) ? RLAT : RTOT;
        const float* modl = MOD + (size_t)l * 33 * 6144;
        const float* xin_lat = (l == 0) ? a.x : a.out; const float* xin_ctx = (l == 0) ? a.ctx : XCTX;
        norm_phase(xin_lat, xin_ctx, a.norm1_g + l * 1024, modl, 0, XN, Mrows, NGW);
        grid.sync();
        if (even) {
            { pg8::Gemm g{XN, (const bf16_t*)(ws + WS_WABIN) + (size_t)li * 3072 * 1024, Mrows, NIN, DM}; pg8::StaticOrder S; S.init(Mrows, NIN, G, bx);
              pg8::EpiBf16<0> E{BIG, NIN, nullptr};
              PH_GEMM(pg8::gemm_phase<pg8::EpiBf16<0>, pg8::StaticOrder, true, true>(glds, g, S, E)); }
            grid.sync();
            ropenorm_phase(BIG, ropec, ropes, a.q_g + li * 128, a.k_g + li * 128, NGW);
            grid.sync();
            const float rd_f[1] = {0};
            (void)rd_f;
            for (int u = bx; u < 1024 + 256 + 128; u += G) {
                if (u < 1024) {
                    const int rnd = u >> 8, v = u & 255, x = v & 7, y = v >> 3; const int grp = rnd * 16 + x * 2 + (y >> 4);
                    const int b = grp >> 1, kvh = grp & 1, h = kvh * 2 + ((y >> 3) & 1), qb = y & 7;
                    const bf16_t* Pl = BIG + (size_t)(b * 2048) * NIN; const bf16_t* Pc = BIG + (size_t)(RLAT + b * 256) * NIN;
                    PH_ATT(attn::body(Pl + (size_t)(qb * 256) * NIN + 2048 + h * 128, Pc + 2560 + kvh * 128, Pc + 2816 + kvh * 128, 256,
                               Pl + 2560 + kvh * 128, Pl + 2816 + kvh * 128, XN + (size_t)(b * 2048 + qb * 256) * DM + 512 + h * 128, 2304, lds));
                    __syncthreads();
                } else if (u < 1280) {
                    const int v = u - 1024, b = v >> 3, h = (v >> 1) & 3, dir = v & 1;
                    const float xd = a.ret_decay[(li * 2 + dir) * 4 + h]; const float lg2 = -log1pf(expf(-xd)) * 1.4426950408889634f;
                    PH_RS(ret_state_unit(BIG, ST, b, h, dir, lg2, lds));
                } else {
                    const int v = u - 1280, b = v >> 2, h = v & 3, kvh = h >> 1;
                    const bf16_t* Pc = BIG + (size_t)(RLAT + b * 256) * NIN;
                    PH_ATT(attn::body(Pc + 2048 + h * 128, Pc + 2560 + kvh * 128, Pc + 2816 + kvh * 128, 256, Pc, Pc, XN + (size_t)(RLAT + b * 256) * DM + 512 + h * 128, 256, lds));
                    __syncthreads();
                }
            }
            grid.sync();
            for (int u = bx; u < 32 * 4 * 18; u += G) {
                const int cid = u % 18, bh = u / 18, b = bh >> 2, h = bh & 3;
                const float xf_ = a.ret_decay[(li * 2 + 0) * 4 + h], xb_ = a.ret_decay[(li * 2 + 1) * 4 + h];
                const float lgf = -log1pf(expf(-xf_)) * 1.4426950408889634f, lgb = -log1pf(expf(-xb_)) * 1.4426950408889634f;
                PH_RO(ret_out_unit(BIG, ST, XN, b, h, cid, lgf, lgb, lds));
            }
            __syncthreads();
            grid.sync();
            { pg8::Gemm g{XN, (const bf16_t*)(ws + WS_WABOUT) + (size_t)li * 1024 * 1024, Mrows, DM, DM}; pg8::StaticOrder S; S.init(Mrows, DM, G, bx);
              pg8::EpiGate E{xin_lat, xin_ctx, a.out, XCTX, modl + 2048};
              PH_GEMM(pg8::gemm_phase<pg8::EpiGate, pg8::StaticOrder, true, true>(glds, g, S, E)); }
            grid.sync();
        } else {
            { pg8::Gemm g{XN, (const bf16_t*)(ws + WS_WCMIN) + (size_t)li * 2048 * 1024, Mrows, 2048, DM}; pg8::StaticOrder S; S.init(Mrows, 2048, G, bx);
              pg8::EpiBf16<1> E{BIG, 2048, SSQ};
              PH_GEMM(pg8::gemm_phase<pg8::EpiBf16<1>, pg8::StaticOrder, true, true>(glds, g, S, E)); }
            grid.sync();
            for (int u = bx; u < (Mrows / 128) * 8; u += G)
                PH_GT(gate_unit(BIG, SSQ, a.cm_v_g + li * 1024, (const bf16_t*)(ws + WS_WSB) + (size_t)li * 8 * 128 * 128, a.cm_b_s + li * 8 * 128, XN, u >> 3, u & 7, lds));
            __syncthreads();
            grid.sync();
            { pg8::Gemm g{XN, (const bf16_t*)(ws + WS_WCMOUT) + (size_t)li * 1024 * 1024, Mrows, DM, DM}; pg8::StaticOrder S; S.init(Mrows, DM, G, bx);
              pg8::EpiGate E{xin_lat, xin_ctx, a.out, XCTX, modl + 2048};
              PH_GEMM(pg8::gemm_phase<pg8::EpiGate, pg8::StaticOrder, true, true>(glds, g, S, E)); }
            grid.sync();
        }
        norm_phase(a.out, XCTX, a.norm2_g + l * 1024, modl, 1, XN, Mrows, NGW);
        grid.sync();
        { pg8::Gemm g{XN, (const bf16_t*)(ws + WS_WFF1) + (size_t)l * 4096 * 1024, Mrows, FF, DM}; pg8::StaticOrder S; S.init(Mrows, FF, G, bx);
          pg8::EpiBf16<2> E{BIG, FF, nullptr};
          PH_GEMM(pg8::gemm_phase<pg8::EpiBf16<2>, pg8::StaticOrder, true, true>(glds, g, S, E)); }
        grid.sync();
        { pg8::Gemm g{BIG, (const bf16_t*)(ws + WS_WFF2) + (size_t)l * 1024 * 4096, Mrows, DM, FF}; pg8::StaticOrder S; S.init(Mrows, DM, G, bx);
          pg8::EpiGate E{a.out, XCTX, a.out, XCTX, modl + 5 * 1024};
          PH_GEMM(pg8::gemm_phase<pg8::EpiGate, pg8::StaticOrder, true, true>(glds, g, S, E)); }
        grid.sync();
    }
}

extern "C" void kernel_launch(void* const* d_in, const int* in_sizes, int n_in, void* d_out, int out_size, void* d_ws, size_t ws_size, hipStream_t stream) {
    static int grid = 0;
    if (grid == 0) {
        if (n_in != 20 || out_size != RLAT * DM || ws_size < WS_END) { fprintf(stderr, "kernel_launch: unexpected shapes: n_in %d out %d ws %zu (need %zu)\n", n_in, out_size, ws_size, (size_t)WS_END); grid = -1; return; }
        int dev = 0, cus = 0, per_cu = 0;
        (void)hipGetDevice(&dev);
        (void)hipDeviceGetAttribute(&cus, hipDeviceAttributeMultiprocessorCount, dev);
        if (hipFuncSetAttribute((const void*)mk_fwd, hipFuncAttributeMaxDynamicSharedMemorySize, LDS_BYTES) != hipSuccess) { fprintf(stderr, "kernel_launch: hipFuncSetAttribute failed\n"); grid = -1; return; }
        (void)hipOccupancyMaxActiveBlocksPerMultiprocessor(&per_cu, (const void*)mk_fwd, 512, LDS_BYTES);
        if (per_cu < 1) { fprintf(stderr, "kernel_launch: occupancy query says %d blocks per CU\n", per_cu); per_cu = 1; }
        grid = cus * per_cu;
    }
    if (grid < 0) return;
    Args a{};
    a.x = (const float*)d_in[0]; a.c = (const float*)d_in[1]; a.ctx = (const float*)d_in[2]; a.c_ctx = (const float*)d_in[3]; a.mod_w = (const float*)d_in[4]; a.mod_b = (const float*)d_in[5];
    a.norm1_g = (const float*)d_in[6]; a.norm2_g = (const float*)d_in[7]; a.ab_w_in = (const float*)d_in[8]; a.ab_w_out = (const float*)d_in[9]; a.ret_decay = (const float*)d_in[10];
    a.q_g = (const float*)d_in[11]; a.k_g = (const float*)d_in[12]; a.cm_w_in = (const float*)d_in[13]; a.cm_v_g = (const float*)d_in[14]; a.cm_w_s = (const float*)d_in[15]; a.cm_b_s = (const float*)d_in[16];
    a.cm_w_out = (const float*)d_in[17]; a.ff_w1 = (const float*)d_in[18]; a.ff_w2 = (const float*)d_in[19];
    a.out = (float*)d_out; a.ws = (unsigned char*)d_ws; a.ph_lo = 0; a.ph_hi = 0;
    void* args[] = {&a};
    hipError_t e = hipLaunchCooperativeKernel((const void*)mk_fwd, dim3(grid), dim3(512), args, LDS_BYTES, stream);
    if (e != hipSuccess) fprintf(stderr, "kernel_launch: cooperative launch failed: %s (grid %d)\n", hipGetErrorString(e), grid);
}
```

```cpp
#include <hip/hip_runtime.h>
#include <hip/hip_cooperative_groups.h>
#include <cstdio>
#include <cstdint>
namespace cg = cooperative_groups;

namespace pg8 {
#define PG8_LAS __attribute__((address_space(3)))
typedef unsigned short bf16_t;
typedef short bf16x8 __attribute__((ext_vector_type(8)));
typedef float f32x4 __attribute__((ext_vector_type(4)));
typedef unsigned u32x4 __attribute__((ext_vector_type(4)));
constexpr int BM = 256, BK = 64, HALF = 128, HTB = HALF * BK * 2, STAGE_BYTES = 8 * HTB, NXCD = 8, WGM = 8;

__host__ __device__ __forceinline__ int lds_byte(int r, int c) { const int st = (r >> 4) * 2 + (c >> 5), rr = r & 15, cc = c & 31, ob = rr * 64 + cc * 2; return st * 1024 + (ob ^ (((ob >> 9) & 1) << 5)); }
__host__ __device__ __forceinline__ void stage_rc(int b, int& R, int& C) { const int st = b / 1024, sb = b % 1024, swz = sb ^ (((sb >> 9) & 1) << 5); R = (st >> 1) * 16 + swz / 64; C = (st & 1) * 32 + (swz % 64) / 2; }
__host__ __device__ __forceinline__ int perm32(int rho) { const int n = rho >> 4, i = rho & 15; return 8 * (i >> 2) + 4 * n + (i & 3); }

struct Unit { int pm, pn; };
struct Gemm { const bf16_t* A; const bf16_t* Bt; int M, N, K; };

struct StaticOrder {
    int nM, nN, nwg, G, c;
    __host__ __device__ void init(int M, int N, int G_, int c_) { nM = M / BM; nN = N / BM; nwg = nM * nN; G = G_; c = c_; }
    __host__ __device__ bool next(int i, Unit& u) const {
        const long L = (long)i * G + c; if (L >= nwg) return false;
        int wgid = (int)L; { const int q = nwg / NXCD, r = nwg % NXCD, xcd = wgid % NXCD, off = wgid / NXCD; wgid = (xcd < r ? xcd * (q + 1) : r * (q + 1) + (xcd - r) * q) + off; }
        const int nig = WGM * nN, gid = wgid / nig, fm = gid * WGM, gsz = (nM - fm) < WGM ? (nM - fm) : WGM;
        u.pm = fm + ((wgid % nig) % gsz); u.pn = (wgid % nig) / gsz; return true;
    }
    __device__ __forceinline__ void a_ready(const Unit&) const {}
    __device__ __forceinline__ void done(const Unit&) const {}
};

__device__ __forceinline__ unsigned cvt_pk_bf16(float lo, float hi) { unsigned r; asm volatile("v_cvt_pk_bf16_f32 %0, %1, %2" : "=v"(r) : "v"(lo), "v"(hi)); return r; }
__device__ __forceinline__ float gelu_tanh(float x) {
    const float u = 0.7978845608f * (x + 0.044715f * x * x * x);
    const float e = __builtin_amdgcn_exp2f(-2.885390082f * u);
    return x * __builtin_amdgcn_rcpf(1.0f + e);
}
constexpr int RLAT_ROWS = 65536;
template <int ACT> struct EpiBf16 {
    static constexpr bool PERM = true, AFTER_DRAIN = false;
    bf16_t* O; int ldc; float* ssq;
    __device__ __forceinline__ void operator()(const f32x4 (&acc)[2][2][4][2], const Unit& u, int wr, int wc, int fr, int fq) const {
        const int row0 = u.pm * BM + wr * 64 + fr; const int col0 = u.pn * BM + wc * 32 + 8 * fq;
        const bool dossq = (ACT == 1) && (u.pn >= 4);
#pragma unroll
        for (int ai = 0; ai < 2; ++ai)
#pragma unroll
            for (int m = 0; m < 4; ++m) { bf16_t* rowp = O + (size_t)(row0 + ai * HALF + m * 16) * ldc + col0; float ss = 0.f;
#pragma unroll
                for (int bj = 0; bj < 2; ++bj) { f32x4 v0 = acc[ai][bj][m][0], v1 = acc[ai][bj][m][1];
                    if (ACT == 1) {
#pragma unroll
                        for (int e = 0; e < 4; ++e) { v0[e] = gelu_tanh(v0[e]); v1[e] = gelu_tanh(v1[e]); }
                        ss += (v0[0] * v0[0] + v0[1] * v0[1]) + (v0[2] * v0[2] + v0[3] * v0[3]) + (v1[0] * v1[0] + v1[1] * v1[1]) + (v1[2] * v1[2] + v1[3] * v1[3]);
                    }
                    if (ACT == 2) {
#pragma unroll
                        for (int e = 0; e < 4; ++e) { const float a = fmaxf(v0[e], 0.f), b = fmaxf(v1[e], 0.f); v0[e] = a * a; v1[e] = b * b; }
                    }
                    u32x4 w; w.x = cvt_pk_bf16(v0[0], v0[1]); w.y = cvt_pk_bf16(v0[2], v0[3]); w.z = cvt_pk_bf16(v1[0], v1[1]); w.w = cvt_pk_bf16(v1[2], v1[3]);
                    *(u32x4*)(rowp + bj * HALF) = w; }
                if (ACT == 1) { if (dossq) { ss += __shfl_xor(ss, 16); ss += __shfl_xor(ss, 32);
                    if (fq == 0) ssq[(size_t)(row0 + ai * HALF + m * 16) * 16 + (u.pn - 4) * 4 + wc] = ss; } }
            }
    }
};
struct EpiGate {
    static constexpr bool PERM = false, AFTER_DRAIN = false;
    bool dummy; const float* xin_lat; const float* xin_ctx; float* xout_lat; float* xout_ctx; const float* modg;
    __device__ __forceinline__ void operator()(const f32x4 (&acc)[2][2][4][2], const Unit& u, int wr, int wc, int fr, int fq) const {
        const bool lat = u.pm < 256; const int bidx = lat ? (u.pm >> 3) : 32;
        const float* xi = lat ? xin_lat + (size_t)u.pm * BM * 1024 : xin_ctx + (size_t)(u.pm - 256) * BM * 1024;
        float* xo = dummy ? xout_ctx + (size_t)(756u << 18) + (size_t)(u.pm & 31) * BM * 1024 : (lat ? xout_lat + (size_t)u.pm * BM * 1024 : xout_ctx + (size_t)(u.pm - 256) * BM * 1024);
        const int col0 = u.pn * BM + wc * 32 + 4 * fq;
        const float* gp = modg + (size_t)bidx * 6144 + col0;
        f32x4 gv[2][2];
#pragma unroll
        for (int bj = 0; bj < 2; ++bj)
#pragma unroll
            for (int n = 0; n < 2; ++n) gv[bj][n] = *(const f32x4*)(gp + bj * HALF + n * 16);
#pragma unroll
        for (int ai = 0; ai < 2; ++ai)
#pragma unroll
            for (int m = 0; m < 4; ++m) { const size_t off = (size_t)(wr * 64 + fr + ai * HALF + m * 16) * 1024 + col0;
#pragma unroll
                for (int bj = 0; bj < 2; ++bj)
#pragma unroll
                    for (int n = 0; n < 2; ++n) { const f32x4 xv = *(const f32x4*)(xi + off + bj * HALF + n * 16);
                        *(f32x4*)(xo + off + bj * HALF + n * 16) = xv + gv[bj][n] * acc[ai][bj][m][n]; }
                if (m & 1) asm volatile("" ::: "memory"); }
    }
};

template <class Epi, class Sched, bool ALIGN_EPI = false, bool SP2 = false>
__device__ __forceinline__ void gemm_phase(PG8_LAS unsigned char* lds, const Gemm g, const Sched& S, const Epi& E) {
    int tid_ = threadIdx.x; asm volatile("" : "+v"(tid_));
    const int tid = tid_, wid = __builtin_amdgcn_readfirstlane(tid >> 6), lane = tid & 63, wr = wid >> 2, wc = wid & 3, fr = lane & 15, fq = lane >> 4;
    const int K = g.K, nt = K / BK;
    unsigned voffA[2], voffB[2];
#pragma unroll
    for (int i = 0; i < 2; ++i) { int R, C; stage_rc(tid * 16 + i * 8192, R, C); const int Rb = Epi::PERM ? ((R & ~31) + perm32(R & 31)) : R;
        voffA[i] = (unsigned)(R * K + C) * 2u; voffB[i] = (unsigned)(Rb * K + C) * 2u; }
    const size_t kstep = (size_t)(BK * 2);
    const size_t hstep = (size_t)HALF * K * 2;
    const size_t tstep = 2 * hstep;
    const unsigned ldsw = (unsigned)wid * 1024u;
    const int aoff = lds_byte(wr * 64 + fr, fq * 8), boff = lds_byte(wc * 32 + fr, fq * 8);
#define PG8_SA(b, h) (((b) * 2 + (h)) * HTB)
#define PG8_SB(b, h) ((4 + (b) * 2 + (h)) * HTB)
#define PG8_STAGE(bufoff, gbase, voff) do { _Pragma("unroll") for (int _i = 0; _i < 2; ++_i) \
        __builtin_amdgcn_global_load_lds((const unsigned*)((const char*)(gbase) + (voff)[_i]), (PG8_LAS unsigned*)(lds + (bufoff) + ldsw + _i * 8192), 16, 0, 0); } while (0)
#define PG8_LDA(dst, b, h) do { _Pragma("unroll") for (int m = 0; m < 4; ++m) _Pragma("unroll") for (int k = 0; k < 2; ++k) dst[m][k] = *(const PG8_LAS bf16x8*)(lds + PG8_SA(b, h) + aoff + m * 2048 + k * 1024); } while (0)
#define PG8_LDB(dst, b, h) do { _Pragma("unroll") for (int n = 0; n < 2; ++n) _Pragma("unroll") for (int k = 0; k < 2; ++k) dst[n][k] = *(const PG8_LAS bf16x8*)(lds + PG8_SB(b, h) + boff + n * 2048 + k * 1024); } while (0)
#define PG8_MMA(ai, bj, At, Bt) do { __builtin_amdgcn_s_setprio(1); _Pragma("unroll") for (int m = 0; m < 4; ++m) _Pragma("unroll") for (int n = 0; n < 2; ++n) _Pragma("unroll") for (int k = 0; k < 2; ++k) \
        acc[ai][bj][m][n] = __builtin_amdgcn_mfma_f32_16x16x32_bf16(Bt[n][k], At[m][k], acc[ai][bj][m][n], 0, 0, 0); __builtin_amdgcn_s_setprio(0); } while (0)
#define PG8_WAIT_V(n) asm volatile("s_waitcnt vmcnt(" #n ")" ::: "memory")
#define PG8_WAIT_L(n) asm volatile("s_waitcnt lgkmcnt(" #n ")" ::: "memory")
#define PG8_BAR __builtin_amdgcn_s_barrier()
#define PG8_SCHED __builtin_amdgcn_sched_barrier(0)
    Unit cur, nxt; int ui = 0;
    if (!S.next(0, cur)) return;
    f32x4 acc[2][2][4][2];
#pragma unroll
    for (int a = 0; a < 2; ++a)
#pragma unroll
        for (int b = 0; b < 2; ++b)
#pragma unroll
            for (int m = 0; m < 4; ++m)
#pragma unroll
                for (int n = 0; n < 2; ++n) acc[a][b][m][n] = (f32x4){0.f, 0.f, 0.f, 0.f};
    bf16x8 At[4][2], B0[2][2], B1[2][2];
    const char* cA = (const char*)g.A + (size_t)cur.pm * tstep; const char* cB = (const char*)g.Bt + (size_t)cur.pn * tstep;
    S.a_ready(cur);
    if constexpr (SP2) {
        PG8_STAGE(PG8_SB(0, 0), cB, voffB); PG8_STAGE(PG8_SB(0, 1), cB + hstep, voffB); PG8_STAGE(PG8_SA(0, 0), cA, voffA); PG8_STAGE(PG8_SA(0, 1), cA + hstep, voffA);
        if (wr == 1) PG8_BAR;
        PG8_WAIT_V(2); PG8_BAR;
        PG8_STAGE(PG8_SB(1, 0), cB + kstep, voffB); PG8_STAGE(PG8_SA(1, 0), cA + kstep, voffA); PG8_STAGE(PG8_SB(1, 1), cB + hstep + kstep, voffB);
        PG8_WAIT_V(6); PG8_BAR;
    } else {
        PG8_STAGE(PG8_SB(0, 0), cB, voffB); PG8_STAGE(PG8_SA(0, 0), cA, voffA); PG8_STAGE(PG8_SB(0, 1), cB + hstep, voffB); PG8_STAGE(PG8_SA(0, 1), cA + hstep, voffA);
        if (wr == 1) PG8_BAR;
        PG8_WAIT_V(4); PG8_BAR;
        PG8_STAGE(PG8_SB(1, 0), cB + kstep, voffB); PG8_STAGE(PG8_SA(1, 0), cA + kstep, voffA); PG8_STAGE(PG8_SB(1, 1), cB + hstep + kstep, voffB);
        PG8_WAIT_V(6); PG8_BAR;
    }
    for (;;) {
        const bool has_next = S.next(ui + 1, nxt);
        const char* nA = has_next ? (const char*)g.A + (size_t)nxt.pm * tstep : cA; const char* nB = has_next ? (const char*)g.Bt + (size_t)nxt.pn * tstep : cB;
        for (int t = 0; t < nt; t += 2) {
            const bool last = (t == nt - 2);
            const char* a1 = cA + (size_t)(t + 1) * kstep;
            const char* a2 = last ? nA : cA + (size_t)(t + 2) * kstep; const char* b2 = last ? nB : cB + (size_t)(t + 2) * kstep;
            const char* a3 = a2 + kstep; const char* b3 = b2 + kstep;
            if (last && has_next) S.a_ready(nxt);
            if constexpr (SP2) {
            PG8_LDB(B0, 0, 0); PG8_LDB(B1, 0, 1); PG8_SCHED; PG8_LDA(At, 0, 0); PG8_STAGE(PG8_SA(1, 1), a1 + hstep, voffA);
            PG8_WAIT_V(8); PG8_WAIT_L(0); PG8_BAR; PG8_MMA(0, 0, At, B0); PG8_MMA(0, 1, At, B1); PG8_BAR; PG8_SCHED;
            PG8_LDA(At, 0, 1); PG8_STAGE(PG8_SB(0, 0), b2, voffB); PG8_STAGE(PG8_SB(0, 1), b2 + hstep, voffB); PG8_STAGE(PG8_SA(0, 0), a2, voffA);
            PG8_WAIT_V(8); PG8_WAIT_L(0); PG8_BAR; PG8_MMA(1, 0, At, B0); PG8_MMA(1, 1, At, B1); PG8_BAR; PG8_SCHED;
            PG8_LDB(B0, 1, 0); PG8_LDB(B1, 1, 1); PG8_SCHED; PG8_LDA(At, 1, 0); PG8_STAGE(PG8_SA(0, 1), a2 + hstep, voffA);
            PG8_WAIT_V(8); PG8_WAIT_L(0); PG8_BAR; PG8_MMA(0, 0, At, B0); PG8_MMA(0, 1, At, B1); PG8_BAR; PG8_SCHED;
            PG8_LDA(At, 1, 1); PG8_STAGE(PG8_SB(1, 0), b3, voffB); PG8_STAGE(PG8_SB(1, 1), b3 + hstep, voffB); PG8_STAGE(PG8_SA(1, 0), a3, voffA);
            PG8_WAIT_V(8); PG8_WAIT_L(0); PG8_BAR; PG8_MMA(1, 0, At, B0); PG8_MMA(1, 1, At, B1); PG8_BAR; PG8_SCHED;
            } else {
            PG8_LDB(B0, 0, 0); PG8_SCHED; PG8_LDA(At, 0, 0); PG8_STAGE(PG8_SA(1, 1), a1 + hstep, voffA);
            PG8_WAIT_L(8); PG8_BAR; PG8_WAIT_L(0); PG8_MMA(0, 0, At, B0); PG8_BAR; PG8_SCHED;
            PG8_LDB(B1, 0, 1); PG8_STAGE(PG8_SB(0, 0), b2, voffB);
            PG8_BAR; PG8_WAIT_L(0); PG8_MMA(0, 1, At, B1); PG8_BAR;
            PG8_LDA(At, 0, 1); PG8_STAGE(PG8_SA(0, 0), a2, voffA);
            PG8_BAR; PG8_WAIT_L(0); PG8_MMA(1, 0, At, B0); PG8_BAR; PG8_SCHED;
            PG8_STAGE(PG8_SB(0, 1), b2 + hstep, voffB);
            PG8_WAIT_V(6); PG8_BAR; PG8_MMA(1, 1, At, B1); PG8_BAR;
            PG8_LDB(B0, 1, 0); PG8_SCHED; PG8_LDA(At, 1, 0); PG8_STAGE(PG8_SA(0, 1), a2 + hstep, voffA);
            PG8_WAIT_L(8); PG8_BAR; PG8_WAIT_L(0); PG8_MMA(0, 0, At, B0); PG8_BAR; PG8_SCHED;
            PG8_LDB(B1, 1, 1); PG8_STAGE(PG8_SB(1, 0), b3, voffB);
            PG8_BAR; PG8_WAIT_L(0); PG8_MMA(0, 1, At, B1); PG8_BAR;
            PG8_LDA(At, 1, 1); PG8_STAGE(PG8_SA(1, 0), a3, voffA);
            PG8_BAR; PG8_WAIT_L(0); PG8_MMA(1, 0, At, B0); PG8_BAR; PG8_SCHED;
            PG8_STAGE(PG8_SB(1, 1), b3 + hstep, voffB);
            PG8_WAIT_V(6); PG8_BAR; PG8_MMA(1, 1, At, B1); PG8_BAR;
            }
        }
        if constexpr (ALIGN_EPI) { if (wr == 0) PG8_BAR; }
        if constexpr (!Epi::AFTER_DRAIN) { E(acc, cur, wr, wc, fr, fq); S.done(cur); }
        if (!has_next) break;
#pragma unroll
        for (int a = 0; a < 2; ++a)
#pragma unroll
            for (int b = 0; b < 2; ++b)
#pragma unroll
                for (int m = 0; m < 4; ++m)
#pragma unroll
                    for (int n = 0; n < 2; ++n) acc[a][b][m][n] = (f32x4){0.f, 0.f, 0.f, 0.f};
        cur = nxt; cA = nA; cB = nB; ++ui;
        if constexpr (ALIGN_EPI) { if (wr == 1) PG8_BAR; }
    }
    PG8_WAIT_V(0);
    if constexpr (!ALIGN_EPI) { if (wr == 0) PG8_BAR; }
    PG8_BAR;
    if constexpr (Epi::AFTER_DRAIN) { E.fused(acc, cur, wr, wc, fr, fq, lds, wid, lane); S.done(cur); }
#undef PG8_SA
#undef PG8_SB
#undef PG8_STAGE
#undef PG8_LDA
#undef PG8_LDB
#undef PG8_MMA
#undef PG8_WAIT_V
#undef PG8_WAIT_L
#undef PG8_BAR
#undef PG8_SCHED
}}

typedef unsigned short bf16_t;
typedef float f32x4 __attribute__((ext_vector_type(4)));
typedef unsigned u32x4 __attribute__((ext_vector_type(4)));
typedef unsigned u32x2 __attribute__((ext_vector_type(2)));
using bf16x8 = __attribute__((ext_vector_type(8))) short;
using s16x4  = __attribute__((ext_vector_type(4))) short;
using f32x16 = __attribute__((ext_vector_type(16))) float;

constexpr int DM = 1024, NB = 32, SEQ = 2048, CTXL = 256, DEPTH = 4, NIN = 3072, FF = 4096;
constexpr int RLAT = NB * SEQ, RCTX = NB * CTXL, RTOT = RLAT + RCTX;
constexpr float EPS = 1e-6f;
constexpr size_t MiB = 1u << 20;
constexpr size_t WS_MOD = 1 * MiB;
constexpr size_t WS_ROPE = 5 * MiB;
constexpr size_t WS_WSB = 6 * MiB;
constexpr size_t WS_SSQ = 7 * MiB;
constexpr size_t WS_WABIN = 12 * MiB;
constexpr size_t WS_WABOUT = 24 * MiB;
constexpr size_t WS_WCMIN = 28 * MiB;
constexpr size_t WS_WCMOUT = 36 * MiB;
constexpr size_t WS_WFF1 = 40 * MiB;
constexpr size_t WS_WFF2 = 72 * MiB;
constexpr size_t WS_XCTX = 104 * MiB;
constexpr size_t WS_XN = 136 * MiB;
constexpr size_t WS_BIG = 280 * MiB;
constexpr size_t WS_ST = WS_BIG + 432 * MiB;
constexpr size_t WS_END = 856 * MiB;
constexpr int LDS_BYTES = 147456;

__device__ __forceinline__ float bf2f(bf16_t v) { return __uint_as_float((unsigned)v << 16); }
__device__ __forceinline__ unsigned f2bf(float f) { unsigned u = __float_as_uint(f); return (u + 0x7fffu + ((u >> 16) & 1u)) >> 16; }
__device__ __forceinline__ unsigned cvtpk(float lo, float hi) { unsigned r; asm volatile("v_cvt_pk_bf16_f32 %0, %1, %2" : "=v"(r) : "v"(lo), "v"(hi)); return r; }
__device__ __forceinline__ float wave_sum(float v) {
#pragma unroll
    for (int o = 1; o < 64; o <<= 1) v += __shfl_xor(v, o);
    return v;
}
#define LDS_WAIT() asm volatile("s_waitcnt lgkmcnt(0)" ::: "memory")
#define SBAR() __builtin_amdgcn_sched_barrier(0)
#define KSWZ(row, colB) ((row) * 256 + ((colB) ^ (((row) & 7) << 4)))
__device__ __forceinline__ int crow(int r, int hi) { return (r & 3) + 8 * (r >> 2) + 4 * hi; }

__device__ __forceinline__ int v_st(int k, int c) { const int kk = (k & ~0xC) | ((k & 4) << 1) | ((k & 8) >> 1); return ((kk >> 3) * 4 + (c >> 5)) * 512 + ((kk & 7) * 32 + (c & 31)) * 2; }
__device__ __forceinline__ int v_rd_base(int lane) { return ((lane & 3) << 3) | (((lane >> 2) & 3) << 6) | (((lane >> 4) & 1) << 5) | (((lane >> 5) & 1) << 8); }
constexpr int v_rd_off(int d0, int ks, int half) { return d0 * 512 + ks * 4096 + half * 2048; }
template <int OFF> __device__ __forceinline__ s16x4 tr_read(int vb) {
    s16x4 r; asm volatile("ds_read_b64_tr_b16 %0, %1 offset:%2" : "=&v"(r) : "v"(vb), "i"(OFF) : "memory"); return r;
}
#define PKLH(L, H) (bf16x8){L[0], L[1], L[2], L[3], H[0], H[1], H[2], H[3]}
template <int D0> __device__ __forceinline__ void pv_one(f32x16& od, int vb, bf16x8 pa0, bf16x8 pa1, bf16x8 pa2, bf16x8 pa3) {
    const s16x4 l0 = tr_read<v_rd_off(D0, 0, 0)>(vb), h0 = tr_read<v_rd_off(D0, 0, 1)>(vb), l1 = tr_read<v_rd_off(D0, 1, 0)>(vb), h1 = tr_read<v_rd_off(D0, 1, 1)>(vb);
    const s16x4 l2 = tr_read<v_rd_off(D0, 2, 0)>(vb), h2 = tr_read<v_rd_off(D0, 2, 1)>(vb), l3 = tr_read<v_rd_off(D0, 3, 0)>(vb), h3 = tr_read<v_rd_off(D0, 3, 1)>(vb);
    asm volatile("s_waitcnt lgkmcnt(0)" ::: "memory"); SBAR();
    od = __builtin_amdgcn_mfma_f32_32x32x16_bf16(pa0, PKLH(l0, h0), od, 0, 0, 0);
    od = __builtin_amdgcn_mfma_f32_32x32x16_bf16(pa1, PKLH(l1, h1), od, 0, 0, 0);
    od = __builtin_amdgcn_mfma_f32_32x32x16_bf16(pa2, PKLH(l2, h2), od, 0, 0, 0);
    od = __builtin_amdgcn_mfma_f32_32x32x16_bf16(pa3, PKLH(l3, h3), od, 0, 0, 0);
}
__device__ __forceinline__ void pv_d0(f32x16* o, int vb, bf16x8 pa0, bf16x8 pa1, bf16x8 pa2, bf16x8 pa3) {
    pv_one<0>(o[0], vb, pa0, pa1, pa2, pa3); pv_one<1>(o[1], vb, pa0, pa1, pa2, pa3); pv_one<2>(o[2], vb, pa0, pa1, pa2, pa3); pv_one<3>(o[3], vb, pa0, pa1, pa2, pa3);
}
__device__ __forceinline__ void pack_p(const f32x16& p0, const f32x16& p1, bf16x8& pa0, bf16x8& pa1, bf16x8& pa2, bf16x8& pa3) {
#define PK4(P, BASE, OUT) do { unsigned a0 = cvtpk(P[BASE + 0], P[BASE + 1]), a1 = cvtpk(P[BASE + 2], P[BASE + 3]);   \
    unsigned b0 = cvtpk(P[BASE + 4], P[BASE + 5]), b1 = cvtpk(P[BASE + 6], P[BASE + 7]);                              \
    auto r0 = __builtin_amdgcn_permlane32_swap(a0, b0, false, false); auto r1 = __builtin_amdgcn_permlane32_swap(a1, b1, false, false); \
    u32x4 w = {r0[0], r1[0], r0[1], r1[1]}; OUT = *reinterpret_cast<bf16x8*>(&w); } while (0)
    PK4(p0, 0, pa0); PK4(p0, 8, pa1); PK4(p1, 0, pa2); PK4(p1, 8, pa3);
#undef PK4
}
__device__ __forceinline__ void qkt(f32x16& p0, f32x16& p1, const char* Ks, const bf16x8* qr, int r32, int hi) {
    p0 = f32x16{}; p1 = f32x16{};
#pragma unroll
    for (int d0 = 0; d0 < 8; ++d0) { int cb = (d0 * 16 + hi * 8) * 2;
        bf16x8 b0 = *reinterpret_cast<const bf16x8*>(Ks + KSWZ(r32, cb));
        bf16x8 b1 = *reinterpret_cast<const bf16x8*>(Ks + KSWZ(32 + r32, cb));
        p0 = __builtin_amdgcn_mfma_f32_32x32x16_bf16(b0, qr[d0], p0, 0, 0, 0);
        p1 = __builtin_amdgcn_mfma_f32_32x32x16_bf16(b1, qr[d0], p1, 0, 0, 0); }
}

namespace attn {
constexpr int D = 128, NW = 8, QBLK = 32, KVBLK = 64;
constexpr float SCALE = 0.088388347648318440f, THR = 8.f;
constexpr int LDQ = NIN, LDK = NIN, LDO = DM;
constexpr size_t SHM_V = KVBLK * D * 2, SHM_K = KVBLK * D * 2;
__device__ __forceinline__ void partialSM(f32x16& p0, f32x16& p1, float& m_reg, float& mn, float& alpha) {
    constexpr float C = SCALE * 1.4426950408889634f;
    float pmax = p0[0];
#pragma unroll
    for (int r = 1; r < 16; ++r) pmax = fmaxf(pmax, p0[r]);
#pragma unroll
    for (int r = 0; r < 16; ++r) pmax = fmaxf(pmax, p1[r]);
    { auto rr = __builtin_amdgcn_permlane32_swap(__float_as_uint(pmax), __float_as_uint(pmax), false, false);
      pmax = fmaxf(__uint_as_float(rr[0]), __uint_as_float(rr[1])); }
    if (__builtin_expect(__all(pmax - m_reg <= THR / SCALE), 1)) { mn = m_reg; alpha = 1.f; }
    else { mn = fmaxf(m_reg, pmax); alpha = __builtin_amdgcn_exp2f((m_reg - mn) * C); m_reg = mn; }
    float mnC = -mn * C;
#pragma unroll
    for (int r = 0; r < 16; ++r) p0[r] = fmaf(p0[r], C, mnC);
#pragma unroll
    for (int r = 0; r < 16; ++r) p1[r] = fmaf(p1[r], C, mnC);
#pragma unroll
    for (int r = 0; r < 16; ++r) p0[r] = __builtin_amdgcn_exp2f(p0[r]);
}
__device__ __forceinline__ void finishSM(f32x16& p0, f32x16& p1, float alpha, float& l_reg, bf16x8& pa0, bf16x8& pa1, bf16x8& pa2, bf16x8& pa3) {
#pragma unroll
    for (int r = 0; r < 16; ++r) p1[r] = __builtin_amdgcn_exp2f(p1[r]);
    float ps = 0;
#pragma unroll
    for (int r = 0; r < 16; ++r) ps += p0[r];
#pragma unroll
    for (int r = 0; r < 16; ++r) ps += p1[r];
    { auto rr = __builtin_amdgcn_permlane32_swap(__float_as_uint(ps), __float_as_uint(ps), false, false);
      ps = __uint_as_float(rr[0]) + __uint_as_float(rr[1]); }
    l_reg = l_reg * alpha + ps;
    pack_p(p0, p1, pa0, pa1, pa2, pa3);
}
__device__ __forceinline__ void body(const bf16_t* __restrict__ Qb, const bf16_t* __restrict__ Kc, const bf16_t* __restrict__ Vc, int nctx,
                                     const bf16_t* __restrict__ Kl, const bf16_t* __restrict__ Vl, bf16_t* __restrict__ Ob, int seq, char* lds) {
    int tid_ = threadIdx.x; asm volatile("" : "+v"(tid_)); const int tid = tid_, wid = tid >> 6, lane = tid & 63, r32 = lane & 31, hi = lane >> 5;
    char* V_lds = lds; char* K_lds = lds + 2 * SHM_V;
    float* wsp = (float*)(lds + 2 * SHM_V + 2 * SHM_K) + wid * 64; float* li_l = wsp; float* al_l = wsp + 32;
    float m_reg = -1e30f, l_reg = 0; f32x16 o[4] = {}; bf16x8 qr[8];
    const bf16_t* Qw = Qb + (long)(wid * QBLK + r32) * LDQ + hi * 8;
#pragma unroll
    for (int d0 = 0; d0 < 8; ++d0) qr[d0] = *reinterpret_cast<const bf16x8*>(Qw + d0 * 16);
    const int sr = tid >> 4, sc = (tid & 15) * 8, vst0 = v_st(sr, sc), vst1 = v_st(32 + sr, sc);
    const int vb0 = (int)(uintptr_t)V_lds + v_rd_base(lane);
    struct { bf16x8 vs0, vs1, ks0, ks1; } sr_[2];
#define SLOAD(i, k0) do { const int _k = (k0); const bf16_t* _kp = (_k < nctx) ? Kc + (long)_k * LDK : Kl + (long)(_k - nctx) * LDK; const bf16_t* _vp = (_k < nctx) ? Vc + (long)_k * LDK : Vl + (long)(_k - nctx) * LDK; \
    sr_[i].vs0 = *reinterpret_cast<const bf16x8*>(&_vp[(long)sr * LDK + sc]); sr_[i].vs1 = *reinterpret_cast<const bf16x8*>(&_vp[(long)(32 + sr) * LDK + sc]); \
    sr_[i].ks0 = *reinterpret_cast<const bf16x8*>(&_kp[(long)sr * LDK + sc]); sr_[i].ks1 = *reinterpret_cast<const bf16x8*>(&_kp[(long)(32 + sr) * LDK + sc]); } while (0)
#define SWRITE(b, i) do { *(bf16x8*)(V_lds + (b) * SHM_V + vst0) = sr_[i].vs0;          \
    *(bf16x8*)(V_lds + (b) * SHM_V + vst1) = sr_[i].vs1; int kc = sc * 2;               \
    *(bf16x8*)(K_lds + (b) * SHM_K + KSWZ(sr, kc)) = sr_[i].ks0;                       \
    *(bf16x8*)(K_lds + (b) * SHM_K + KSWZ(32 + sr, kc)) = sr_[i].ks1; } while (0)
#define SWAIT() asm volatile("s_waitcnt vmcnt(4)" ::: "memory")
#define RESC(a) do { if (__any((a) < 1.f)) { if (hi == 0) al_l[r32] = (a); asm volatile("s_waitcnt lgkmcnt(0)" ::: "memory"); \
    _Pragma("unroll") for (int d = 0; d < 4; ++d) _Pragma("unroll") for (int r = 0; r < 16; ++r) o[d][r] *= al_l[crow(r, hi)]; } } while (0)
    f32x16 pA0, pA1, pB0, pB1; float mnA, mnB, alA, alB; bf16x8 pa0, pa1, pa2, pa3; const int NT = seq / KVBLK;
    constexpr int SE = 0, SO = 1;
    SLOAD(SE, 0); asm volatile("s_waitcnt vmcnt(0)" ::: "memory"); SWRITE(0, SE); __syncthreads();
    qkt(pA0, pA1, K_lds, qr, r32, hi); partialSM(pA0, pA1, m_reg, mnA, alA);
    SLOAD(SO, KVBLK); if (2 < NT) SLOAD(SE, 2 * KVBLK);
    SWAIT(); SWRITE(1, SO); __syncthreads();
    for (int j = 1; j + 1 < NT; j += 2) {
        SBAR(); qkt(pB0, pB1, K_lds + SHM_K, qr, r32, hi);
        finishSM(pA0, pA1, alA, l_reg, pa0, pa1, pa2, pa3); SBAR();
        SLOAD(SO, (j + 2) * KVBLK); SBAR();
        pv_d0(o, vb0, pa0, pa1, pa2, pa3); partialSM(pB0, pB1, m_reg, mnB, alB);
        __syncthreads(); SWAIT(); SWRITE(0, SE);
        RESC(alB); __syncthreads();
        SBAR(); qkt(pA0, pA1, K_lds, qr, r32, hi);
        finishSM(pB0, pB1, alB, l_reg, pa0, pa1, pa2, pa3); SBAR();
        if (j + 3 < NT) SLOAD(SE, (j + 3) * KVBLK); SBAR();
        pv_d0(o, vb0 + (int)SHM_V, pa0, pa1, pa2, pa3); partialSM(pA0, pA1, m_reg, mnA, alA);
        __syncthreads(); SWAIT(); SWRITE(1, SO);
        RESC(alA); __syncthreads();
    }
    SBAR(); qkt(pB0, pB1, K_lds + SHM_K, qr, r32, hi);
    finishSM(pA0, pA1, alA, l_reg, pa0, pa1, pa2, pa3); SBAR();
    pv_d0(o, vb0, pa0, pa1, pa2, pa3); partialSM(pB0, pB1, m_reg, mnB, alB);
    __syncthreads(); RESC(alB);
    finishSM(pB0, pB1, alB, l_reg, pa0, pa1, pa2, pa3); SBAR();
    pv_d0(o, vb0 + (int)SHM_V, pa0, pa1, pa2, pa3);
    if (hi == 0) li_l[r32] = l_reg; asm volatile("s_waitcnt lgkmcnt(0)" ::: "memory");
    float rli[16];
#pragma unroll
    for (int r = 0; r < 16; ++r) rli[r] = __builtin_amdgcn_rcpf(li_l[crow(r, hi)]);
    bf16_t* Ow = Ob + (long)(wid * QBLK) * LDO;
#pragma unroll
    for (int r = 0; r < 16; ++r) { int orow = crow(r, hi);
#pragma unroll
        for (int d0 = 0; d0 < 4; ++d0) Ow[(long)orow * LDO + d0 * 32 + r32] = (bf16_t)f2bf(o[d0][r] * rli[r]); }
#undef SLOAD
#undef SWRITE
#undef SWAIT
#undef RESC
}
}

struct Args {
    const float* x; const float* c; const float* ctx; const float* c_ctx; const float* mod_w; const float* mod_b;
    const float* norm1_g; const float* norm2_g; const float* ab_w_in; const float* ab_w_out; const float* ret_decay;
    const float* q_g; const float* k_g; const float* cm_w_in; const float* cm_v_g; const float* cm_w_s; const float* cm_b_s;
    const float* cm_w_out; const float* ff_w1; const float* ff_w2;
    float* out; unsigned char* ws; int ph_lo, ph_hi;
};

__device__ __forceinline__ void transpose_item(const float* W, int K, int N, bf16_t* WT, float* scr, int item, int lane) {
    const int nblk = N / 32, kb = item / nblk, nb = item % nblk, k0 = 64 * kb, n0 = 32 * nb;
#pragma unroll 8
    for (int i = 0; i < 32; ++i) { const int kk = 2 * i + (lane >> 5); scr[kk * 33 + (lane & 31)] = W[(size_t)(k0 + kk) * N + n0 + (lane & 31)]; }
    LDS_WAIT(); asm volatile("" ::: "memory");
    const int c = lane & 7;
#pragma unroll
    for (int j = 0; j < 4; ++j) { const int n = (lane >> 3) + 8 * j; const float* s = scr + (8 * c) * 33 + n;
        u32x4 o; o.x = cvtpk(s[0 * 33], s[1 * 33]); o.y = cvtpk(s[2 * 33], s[3 * 33]); o.z = cvtpk(s[4 * 33], s[5 * 33]); o.w = cvtpk(s[6 * 33], s[7 * 33]);
        *(u32x4*)(WT + (size_t)(n0 + n) * K + k0 + 8 * c) = o; }
    LDS_WAIT(); asm volatile("" ::: "memory");
}

__device__ __forceinline__ void prologue(const Args& a, char* lds, int G) {
    int tid_ = threadIdx.x; asm volatile("" : "+v"(tid_)); const int tid = tid_, lane = tid & 63, wave = tid >> 6;
    const int gw = blockIdx.x * 8 + wave, NGW = G * 8;
    unsigned char* ws = a.ws;
    float* scr = (float*)(lds + wave * 16384);
    constexpr int I_ABIN = 16 * 96, I_SQ = 16 * 32, I_CMIN = 16 * 64, I_FF = 16 * 128;
    constexpr int NITEMS = 2 * I_ABIN + 2 * I_SQ + 2 * I_CMIN + 2 * I_SQ + 4 * I_FF + 4 * I_FF;
    for (int it = gw; it < NITEMS; it += NGW) {
        int r = it;
        if (r < 2 * I_ABIN) { const int i = r / I_ABIN; transpose_item(a.ab_w_in + (size_t)i * 1024 * 3072, 1024, 3072, (bf16_t*)(ws + WS_WABIN) + (size_t)i * 3072 * 1024, scr, r % I_ABIN, lane); continue; } r -= 2 * I_ABIN;
        if (r < 2 * I_SQ) { const int i = r / I_SQ; transpose_item(a.ab_w_out + (size_t)i * 1024 * 1024, 1024, 1024, (bf16_t*)(ws + WS_WABOUT) + (size_t)i * 1024 * 1024, scr, r % I_SQ, lane); continue; } r -= 2 * I_SQ;
        if (r < 2 * I_CMIN) { const int i = r / I_CMIN; transpose_item(a.cm_w_in + (size_t)i * 1024 * 2048, 1024, 2048, (bf16_t*)(ws + WS_WCMIN) + (size_t)i * 2048 * 1024, scr, r % I_CMIN, lane); continue; } r -= 2 * I_CMIN;
        if (r < 2 * I_SQ) { const int i = r / I_SQ; transpose_item(a.cm_w_out + (size_t)i * 1024 * 1024, 1024, 1024, (bf16_t*)(ws + WS_WCMOUT) + (size_t)i * 1024 * 1024, scr, r % I_SQ, lane); continue; } r -= 2 * I_SQ;
        if (r < 4 * I_FF) { const int i = r / I_FF; transpose_item(a.ff_w1 + (size_t)i * 1024 * 4096, 1024, 4096, (bf16_t*)(ws + WS_WFF1) + (size_t)i * 4096 * 1024, scr, r % I_FF, lane); continue; } r -= 4 * I_FF;
        { const int i = r / I_FF; transpose_item(a.ff_w2 + (size_t)i * 4096 * 1024, 4096, 1024, (bf16_t*)(ws + WS_WFF2) + (size_t)i * 1024 * 4096, scr, r % I_FF, lane); }
    }
    { bf16_t* wsb = (bf16_t*)(ws + WS_WSB);
      for (int i = blockIdx.x * 512 + tid; i < 2 * 8 * 128 * 128 / 2; i += G * 512) { const float2 v = ((const float2*)a.cm_w_s)[i]; ((unsigned*)wsb)[i] = cvtpk(v.x, v.y); } }
    { float* rc = (float*)(ws + WS_ROPE); float* rs = rc + 2048 * 64;
      for (int i = blockIdx.x * 512 + tid; i < 2048 * 64; i += G * 512) { const int t = i >> 6, j = i & 63; const int f = j & 31;
          const float inv = exp2f(-(float)f * (13.287712379549449f / 32.0f));
          const float pos = (j < 32) ? (float)(t >> 6) : (float)(t & 63);
          const float ang = pos * inv; rc[i] = cosf(ang); rs[i] = sinf(ang); } }
    __syncthreads();
    float* T = (float*)lds;
    float* red = (float*)(lds + 81920);
    float* MOD = (float*)(ws + WS_MOD);
#pragma unroll 1
    for (int pass = 0; pass < 2; ++pass) {
        const int j0 = pass * 17;
        for (int e = tid; e < 17 * 1024; e += 512) { const int jj = e >> 10, k = e & 1023, j = j0 + jj; float v = 0.f;
            if (j < 33) { const float cv = (j < 32) ? a.c[j * 1024 + k] : a.c_ctx[k]; v = cv / (1.0f + __expf(-cv)); }
            T[k * 20 + jj] = v; }
        __syncthreads();
        for (int item = blockIdx.x; item < 4 * 96; item += G) {
            const int l = item / 96, n0 = (item % 96) * 64;
            float acc[17];
#pragma unroll
            for (int jj = 0; jj < 17; ++jj) acc[jj] = 0.f;
            const float* wp = a.mod_w + ((size_t)l * 1024 + wave * 128) * 6144 + n0 + lane;
#pragma unroll 4
            for (int kk = 0; kk < 128; ++kk) { const float wv = wp[(size_t)kk * 6144]; const float* tp = T + (wave * 128 + kk) * 20;
                const f32x4 t0 = *(const f32x4*)(tp), t1 = *(const f32x4*)(tp + 4), t2 = *(const f32x4*)(tp + 8), t3 = *(const f32x4*)(tp + 12); const float t16 = tp[16];
                acc[0] += t0[0] * wv; acc[1] += t0[1] * wv; acc[2] += t0[2] * wv; acc[3] += t0[3] * wv;
                acc[4] += t1[0] * wv; acc[5] += t1[1] * wv; acc[6] += t1[2] * wv; acc[7] += t1[3] * wv;
                acc[8] += t2[0] * wv; acc[9] += t2[1] * wv; acc[10] += t2[2] * wv; acc[11] += t2[3] * wv;
                acc[12] += t3[0] * wv; acc[13] += t3[1] * wv; acc[14] += t3[2] * wv; acc[15] += t3[3] * wv; acc[16] += t16 * wv; }
#pragma unroll
            for (int jj = 0; jj < 17; ++jj) red[(jj * 8 + wave) * 64 + lane] = acc[jj];
            __syncthreads();
            for (int e = tid; e < 17 * 64; e += 512) { const int jj = e >> 6, ln = e & 63, j = j0 + jj; float s = 0.f;
#pragma unroll
                for (int w = 0; w < 8; ++w) s += red[(jj * 8 + w) * 64 + ln];
                if (j < 33) MOD[((size_t)l * 33 + j) * 6144 + n0 + ln] = s + a.mod_b[l * 6144 + n0 + ln]; }
            __syncthreads();
        }
        __syncthreads();
    }
}

__device__ __forceinline__ void norm_phase(const float* xlat, const float* xctx, const float* g, const float* modl, int which, bf16_t* XN, int Mrows, int ngw) {
    int tid_ = threadIdx.x; asm volatile("" : "+v"(tid_)); const int lane = tid_ & 63, gw = blockIdx.x * 8 + (tid_ >> 6);
    for (int r = gw; r < Mrows; r += ngw) {
        const float* src = r < RLAT ? xlat + (size_t)r * 1024 : xctx + (size_t)(r - RLAT) * 1024;
        const int bidx = r < RLAT ? (r >> 11) : 32;
        const float* mp = modl + (size_t)bidx * 6144 + which * 3072;
        f32x4 v[4]; float s = 0.f;
#pragma unroll
        for (int j = 0; j < 4; ++j) { v[j] = ((const f32x4*)src)[lane + 64 * j]; s += (v[j][0] * v[j][0] + v[j][1] * v[j][1]) + (v[j][2] * v[j][2] + v[j][3] * v[j][3]); }
        const float rinv = rsqrtf(wave_sum(s) * (1.0f / 1024.0f) + EPS);
        u32x2* o8 = (u32x2*)(XN + (size_t)r * 1024);
#pragma unroll
        for (int j = 0; j < 4; ++j) { const int c4 = lane + 64 * j; const f32x4 gv = ((const f32x4*)g)[c4], sh = ((const f32x4*)mp)[c4], sc = ((const f32x4*)(mp + 1024))[c4];
            const f32x4 y = (v[j] * rinv * gv) * (sc + 1.0f) + sh; u32x2 w; w.x = cvtpk(y[0], y[1]); w.y = cvtpk(y[2], y[3]); o8[c4] = w; }
    }
}

__device__ __forceinline__ void ropenorm_phase(bf16_t* P, const float* ropec, const float* ropes, const float* qg, const float* kg, int ngw) {
    int tid_ = threadIdx.x; asm volatile("" : "+v"(tid_)); const int lane = tid_ & 63, gw = blockIdx.x * 8 + (tid_ >> 6);
    const int sub = lane & 7, hs = lane >> 3;
    float ga1[8], ga2[8];
    { const float* gsel = hs < 4 ? qg : kg;
#pragma unroll
      for (int e = 0; e < 8; ++e) { ga1[e] = gsel[sub * 8 + e]; ga2[e] = gsel[64 + sub * 8 + e]; } }
    const int col0 = (hs < 4 ? hs * 128 : 512 + (hs - 4) * 128) + sub * 8;
    const int col1 = (hs < 4 ? 2048 + hs * 128 : 2560 + ((hs - 4) & 1) * 128) + sub * 8;
    const float mul0 = hs < 4 ? 1.0f : 0.088388347648318440f;
    for (int r = gw; r < RTOT; r += ngw) {
        bf16_t* prow = P + (size_t)r * NIN; const bool lat = r < RLAT;
        float cs[8], sn[8];
        if (lat) { const int t = r & 2047; const f32x4 c0 = *(const f32x4*)(ropec + t * 64 + sub * 8), c1 = *(const f32x4*)(ropec + t * 64 + sub * 8 + 4);
                   const f32x4 s0 = *(const f32x4*)(ropes + t * 64 + sub * 8), s1 = *(const f32x4*)(ropes + t * 64 + sub * 8 + 4);
#pragma unroll
                   for (int e = 0; e < 4; ++e) { cs[e] = c0[e]; cs[4 + e] = c1[e]; sn[e] = s0[e]; sn[4 + e] = s1[e]; } }
        else {
#pragma unroll
            for (int e = 0; e < 8; ++e) { cs[e] = 1.f; sn[e] = 0.f; } }
        const bf16x8 a1 = *reinterpret_cast<const bf16x8*>(prow + col0), a2 = *reinterpret_cast<const bf16x8*>(prow + col0 + 64);
        const bf16x8 b1 = *reinterpret_cast<const bf16x8*>(prow + col1), b2 = *reinterpret_cast<const bf16x8*>(prow + col1 + 64);
        if (lat || hs >= 4) { float o1[8], o2[8];
#pragma unroll
            for (int e = 0; e < 8; ++e) { const float x1 = bf2f((bf16_t)a1[e]) * mul0, x2 = bf2f((bf16_t)a2[e]) * mul0; o1[e] = x1 * cs[e] - x2 * sn[e]; o2[e] = x1 * sn[e] + x2 * cs[e]; }
            u32x4 w1, w2; w1.x = cvtpk(o1[0], o1[1]); w1.y = cvtpk(o1[2], o1[3]); w1.z = cvtpk(o1[4], o1[5]); w1.w = cvtpk(o1[6], o1[7]);
            w2.x = cvtpk(o2[0], o2[1]); w2.y = cvtpk(o2[2], o2[3]); w2.z = cvtpk(o2[4], o2[5]); w2.w = cvtpk(o2[6], o2[7]);
            *(u32x4*)(prow + col0) = w1; *(u32x4*)(prow + col0 + 64) = w2; }
        { float y1[8], y2[8]; float ss = 0.f;
#pragma unroll
          for (int e = 0; e < 8; ++e) { y1[e] = bf2f((bf16_t)b1[e]); y2[e] = bf2f((bf16_t)b2[e]); ss += y1[e] * y1[e] + y2[e] * y2[e]; }
          ss += __shfl_xor(ss, 1); ss += __shfl_xor(ss, 2); ss += __shfl_xor(ss, 4);
          const float rinv = rsqrtf(ss * (1.0f / 128.0f) + EPS);
          if (hs < 6) { float o1[8], o2[8];
#pragma unroll
            for (int e = 0; e < 8; ++e) { const float x1 = y1[e] * rinv * ga1[e], x2 = y2[e] * rinv * ga2[e]; o1[e] = x1 * cs[e] - x2 * sn[e]; o2[e] = x1 * sn[e] + x2 * cs[e]; }
            u32x4 w1, w2; w1.x = cvtpk(o1[0], o1[1]); w1.y = cvtpk(o1[2], o1[3]); w1.z = cvtpk(o1[4], o1[5]); w1.w = cvtpk(o1[6], o1[7]);
            w2.x = cvtpk(o2[0], o2[1]); w2.y = cvtpk(o2[2], o2[3]); w2.z = cvtpk(o2[4], o2[5]); w2.w = cvtpk(o2[6], o2[7]);
            *(u32x4*)(prow + col1) = w1; *(u32x4*)(prow + col1 + 64) = w2; } }
    }
}

__device__ __forceinline__ int chunk_rowbase(int b, int cid) { return cid < 2 ? RLAT + b * 256 + cid * 128 : b * 2048 + (cid - 2) * 128; }

__device__ __forceinline__ void ret_state_unit(const bf16_t* P, bf16_t* ST, int b, int h, int dir, float lg2, char* lds) {
    int tid_ = threadIdx.x; asm volatile("" : "+v"(tid_)); const int tid = tid_, wid = tid >> 6, lane = tid & 63, r32 = lane & 31, hi = lane >> 5;
    const int db = wid & 3, eh = wid >> 2;
    const int sr = tid >> 4, sc = (tid & 15) * 8;
    char* Kt = lds; char* Vt = lds + 32768;
    const int vbA = (int)(uintptr_t)Kt + v_rd_base(lane) + db * 512;
    const int vbB = (int)(uintptr_t)Vt + v_rd_base(lane) + eh * 1024;
    const float cd = exp2f(128.0f * lg2);
    f32x16 st[2] = {};
    bf16_t* STu = ST + (size_t)((b * 4 + h) * 2 + dir) * 18 * 16384;
#pragma unroll 1
    for (int s = 0; s < 18; ++s) {
        const int cid = dir == 0 ? s : (s == 0 ? 1 : (s == 1 ? 0 : 19 - s));
        bf16_t* Sp = STu + (size_t)cid * 16384;
#pragma unroll
        for (int t = 0; t < 2; ++t)
#pragma unroll
            for (int rg = 0; rg < 4; ++rg) { const int e = (2 * eh + t) * 32 + r32, d = db * 32 + 8 * rg + 4 * hi;
                u32x2 w; w.x = cvtpk(st[t][4 * rg + 0], st[t][4 * rg + 1]); w.y = cvtpk(st[t][4 * rg + 2], st[t][4 * rg + 3]); *(u32x2*)(Sp + e * 128 + d) = w; }
        if (s == 17) break;
        const int rowbase = chunk_rowbase(b, cid);
        __syncthreads();
#pragma unroll
        for (int q = 0; q < 4; ++q) { const int key = q * 32 + sr; const bf16_t* pr = P + (size_t)(rowbase + key) * NIN + h * 128 + sc;
            const bf16x8 kv = *reinterpret_cast<const bf16x8*>(pr + 512); const bf16x8 vv = *reinterpret_cast<const bf16x8*>(pr + 1024);
            const float kd = exp2f(lg2 * (float)(dir ? key : 127 - key));
            u32x4 w;
            w.x = cvtpk(bf2f((bf16_t)vv[0]) * kd, bf2f((bf16_t)vv[1]) * kd); w.y = cvtpk(bf2f((bf16_t)vv[2]) * kd, bf2f((bf16_t)vv[3]) * kd);
            w.z = cvtpk(bf2f((bf16_t)vv[4]) * kd, bf2f((bf16_t)vv[5]) * kd); w.w = cvtpk(bf2f((bf16_t)vv[6]) * kd, bf2f((bf16_t)vv[7]) * kd);
            const int off = (key >> 6) * 16384 + v_st(key & 63, sc);
            *(bf16x8*)(Kt + off) = kv; *(u32x4*)(Vt + off) = w; }
        __syncthreads();
        f32x16 acc[2] = {};
#pragma unroll
        for (int tile = 0; tile < 2; ++tile) {
#define RS_STEP(KS) do { const s16x4 al = tr_read<v_rd_off(0, KS, 0)>(vbA + tile * 16384), ah = tr_read<v_rd_off(0, KS, 1)>(vbA + tile * 16384); \
            const s16x4 b0l = tr_read<v_rd_off(0, KS, 0)>(vbB + tile * 16384), b0h = tr_read<v_rd_off(0, KS, 1)>(vbB + tile * 16384); \
            const s16x4 b1l = tr_read<v_rd_off(1, KS, 0)>(vbB + tile * 16384), b1h = tr_read<v_rd_off(1, KS, 1)>(vbB + tile * 16384); \
            asm volatile("s_waitcnt lgkmcnt(0)" ::: "memory"); SBAR(); \
            acc[0] = __builtin_amdgcn_mfma_f32_32x32x16_bf16(PKLH(al, ah), PKLH(b0l, b0h), acc[0], 0, 0, 0); \
            acc[1] = __builtin_amdgcn_mfma_f32_32x32x16_bf16(PKLH(al, ah), PKLH(b1l, b1h), acc[1], 0, 0, 0); } while (0)
            RS_STEP(0); RS_STEP(1); RS_STEP(2); RS_STEP(3);
#undef RS_STEP
        }
#pragma unroll
        for (int t = 0; t < 2; ++t)
#pragma unroll
            for (int r = 0; r < 16; ++r) st[t][r] = st[t][r] * cd + acc[t][r];
    }
    __syncthreads();
}

__device__ __forceinline__ void ret_out_unit(const bf16_t* P, const bf16_t* ST, bf16_t* O, int b, int h, int cid, float lgf, float lgb, char* lds) {
    int tid_ = threadIdx.x; asm volatile("" : "+v"(tid_)); const int tid = tid_, wid = tid >> 6, lane = tid & 63, r32 = lane & 31, hi = lane >> 5;
    const int rb = wid & 3, eh = wid >> 2;
    const int sr = tid >> 4, sc = (tid & 15) * 8;
    char* Kt = lds; char* Vt = lds + 32768; char* Sf = lds + 65536; char* Sb = lds + 98304;
    const int rowbase = chunk_rowbase(b, cid);
    const bf16_t* Sfg = ST + (size_t)(((b * 4 + h) * 2 + 0) * 18 + cid) * 16384;
    const bf16_t* Sbg = ST + (size_t)(((b * 4 + h) * 2 + 1) * 18 + cid) * 16384;
    __syncthreads();
#pragma unroll
    for (int q = 0; q < 4; ++q) { const int key = q * 32 + sr; const bf16_t* pr = P + (size_t)(rowbase + key) * NIN + h * 128 + sc;
        const bf16x8 kv = *reinterpret_cast<const bf16x8*>(pr + 512); const bf16x8 vv = *reinterpret_cast<const bf16x8*>(pr + 1024);
        const bf16x8 sf = *reinterpret_cast<const bf16x8*>(Sfg + key * 128 + sc); const bf16x8 sb = *reinterpret_cast<const bf16x8*>(Sbg + key * 128 + sc);
        *(bf16x8*)(Kt + (key >> 6) * 16384 + KSWZ(key & 63, sc * 2)) = kv;
        *(bf16x8*)(Vt + (key >> 6) * 16384 + v_st(key & 63, sc)) = vv;
        *(bf16x8*)(Sf + KSWZ(key, sc * 2)) = sf; *(bf16x8*)(Sb + KSWZ(key, sc * 2)) = sb; }
    bf16x8 qr[8];
    { const bf16_t* Qw = P + (size_t)(rowbase + rb * 32 + r32) * NIN + h * 128 + hi * 8;
#pragma unroll
      for (int d0 = 0; d0 < 8; ++d0) qr[d0] = *reinterpret_cast<const bf16x8*>(Qw + d0 * 16); }
    __syncthreads();
    f32x16 o[2] = {}, xf[2] = {}, xb[2] = {};
    const int irow = rb * 32 + r32;
    const int vb = (int)(uintptr_t)Vt + v_rd_base(lane) + eh * 1024;
#pragma unroll
    for (int jt = 0; jt < 2; ++jt) {
        f32x16 p0, p1; qkt(p0, p1, Kt + jt * 16384, qr, r32, hi);
#pragma unroll
        for (int r = 0; r < 16; ++r) { const int j0 = jt * 64 + crow(r, hi), d0 = irow - j0, d1 = d0 - 32;
            const float w0 = d0 > 0 ? exp2f(lgf * (float)d0) : (d0 < 0 ? exp2f(lgb * (float)(-d0)) : 2.0f);
            const float w1 = d1 > 0 ? exp2f(lgf * (float)d1) : (d1 < 0 ? exp2f(lgb * (float)(-d1)) : 2.0f);
            p0[r] *= w0; p1[r] *= w1; }
        bf16x8 pa0, pa1, pa2, pa3; pack_p(p0, p1, pa0, pa1, pa2, pa3);
        pv_one<0>(o[0], vb + jt * 16384, pa0, pa1, pa2, pa3); pv_one<1>(o[1], vb + jt * 16384, pa0, pa1, pa2, pa3);
    }
#pragma unroll
    for (int t = 0; t < 2; ++t)
#pragma unroll
        for (int d0 = 0; d0 < 8; ++d0) { const int e = (2 * eh + t) * 32 + r32, cb = (d0 * 16 + hi * 8) * 2;
            const bf16x8 bf = *reinterpret_cast<const bf16x8*>(Sf + KSWZ(e, cb)); const bf16x8 bb = *reinterpret_cast<const bf16x8*>(Sb + KSWZ(e, cb));
            xf[t] = __builtin_amdgcn_mfma_f32_32x32x16_bf16(qr[d0], bf, xf[t], 0, 0, 0);
            xb[t] = __builtin_amdgcn_mfma_f32_32x32x16_bf16(qr[d0], bb, xb[t], 0, 0, 0); }
    __syncthreads();
    float* OT = (float*)lds;
#pragma unroll
    for (int r = 0; r < 16; ++r) { const int i = rb * 32 + crow(r, hi); const float wf = exp2f(lgf * (float)(i + 1)), wb = exp2f(lgb * (float)(128 - i));
#pragma unroll
        for (int t = 0; t < 2; ++t) OT[i * 132 + (2 * eh + t) * 32 + r32] = o[t][r] + wf * xf[t][r] + wb * xb[t][r]; }
    __syncthreads();
    { const int row = tid >> 2, qd = tid & 3; const float* op = OT + row * 132 + qd * 32; f32x4 v[8]; float s = 0.f;
#pragma unroll
      for (int j = 0; j < 8; ++j) { v[j] = *(const f32x4*)(op + 4 * j); s += (v[j][0] + v[j][1]) + (v[j][2] + v[j][3]); }
      s += __shfl_xor(s, 1); s += __shfl_xor(s, 2); const float mu = s * (1.0f / 128.0f); float q = 0.f;
#pragma unroll
      for (int j = 0; j < 8; ++j) { v[j] = v[j] - mu; q += (v[j][0] * v[j][0] + v[j][1] * v[j][1]) + (v[j][2] * v[j][2] + v[j][3] * v[j][3]); }
      q += __shfl_xor(q, 1); q += __shfl_xor(q, 2); const float rstd = rsqrtf(q * (1.0f / 128.0f) + EPS);
      const bf16_t* gp = P + (size_t)(rowbase + row) * NIN + 1536 + h * 128 + qd * 32; bf16_t* od = O + (size_t)(rowbase + row) * DM + h * 128 + qd * 32;
#pragma unroll
      for (int j = 0; j < 4; ++j) { const bf16x8 gv = *reinterpret_cast<const bf16x8*>(gp + 8 * j); float y[8];
#pragma unroll
          for (int e = 0; e < 8; ++e) { const float g = bf2f((bf16_t)gv[e]); const float sg = g / (1.0f + __expf(-g)); y[e] = v[2 * j + (e >> 2)][e & 3] * rstd * sg; }
          u32x4 w; w.x = cvtpk(y[0], y[1]); w.y = cvtpk(y[2], y[3]); w.z = cvtpk(y[4], y[5]); w.w = cvtpk(y[6], y[7]); *(u32x4*)(od + 8 * j) = w; } }
}

__device__ __forceinline__ void gate_unit(const bf16_t* Z, const float* ssq, const float* vg, const bf16_t* wsb, const float* bs, bf16_t* Gout, int chunk, int g, char* lds) {
    int tid_ = threadIdx.x; asm volatile("" : "+v"(tid_)); const int tid = tid_, wid = tid >> 6, lane = tid & 63, r32 = lane & 31, hi = lane >> 5;
    const int pb = wid & 3, dh = wid >> 2;
    const int sr = tid >> 4, sc = (tid & 15) * 8;
    const int rowbase = chunk * 128;
    char* Vt = lds;
    bf16x8 af[8];
    { const bf16_t* wp = wsb + (size_t)(g * 128 + pb * 32 + r32) * 128 + hi * 8;
#pragma unroll
      for (int k8 = 0; k8 < 8; ++k8) af[k8] = *reinterpret_cast<const bf16x8*>(wp + k8 * 16); }
    const f32x4 g0 = *(const f32x4*)(vg + g * 128 + sc), g1 = *(const f32x4*)(vg + g * 128 + sc + 4);
    __syncthreads();
#pragma unroll
    for (int q = 0; q < 4; ++q) { const int key = q * 32 + sr; const int row = rowbase + key;
        const bf16x8 vv = *reinterpret_cast<const bf16x8*>(Z + (size_t)row * 2048 + 1024 + g * 128 + sc);
        const f32x4 s0 = *(const f32x4*)(ssq + (size_t)row * 16), s1 = *(const f32x4*)(ssq + (size_t)row * 16 + 4), s2 = *(const f32x4*)(ssq + (size_t)row * 16 + 8), s3 = *(const f32x4*)(ssq + (size_t)row * 16 + 12);
        const float tot = ((s0[0] + s0[1]) + (s0[2] + s0[3])) + ((s1[0] + s1[1]) + (s1[2] + s1[3])) + ((s2[0] + s2[1]) + (s2[2] + s2[3])) + ((s3[0] + s3[1]) + (s3[2] + s3[3]));
        const float rinv = rsqrtf(tot * (1.0f / 1024.0f) + EPS);
        u32x4 w;
        w.x = cvtpk(bf2f((bf16_t)vv[0]) * rinv * g0[0], bf2f((bf16_t)vv[1]) * rinv * g0[1]); w.y = cvtpk(bf2f((bf16_t)vv[2]) * rinv * g0[2], bf2f((bf16_t)vv[3]) * rinv * g0[3]);
        w.z = cvtpk(bf2f((bf16_t)vv[4]) * rinv * g1[0], bf2f((bf16_t)vv[5]) * rinv * g1[1]); w.w = cvtpk(bf2f((bf16_t)vv[6]) * rinv * g1[2], bf2f((bf16_t)vv[7]) * rinv * g1[3]);
        *(u32x4*)(Vt + (key >> 6) * 16384 + v_st(key & 63, sc)) = w; }
    __syncthreads();
    f32x16 acc[2] = {};
    const int vb = (int)(uintptr_t)Vt + v_rd_base(lane) + dh * 1024;
#pragma unroll
    for (int tile = 0; tile < 2; ++tile) {
#define GT_STEP(KS) do { const s16x4 b0l = tr_read<v_rd_off(0, KS, 0)>(vb + tile * 16384), b0h = tr_read<v_rd_off(0, KS, 1)>(vb + tile * 16384); \
        const s16x4 b1l = tr_read<v_rd_off(1, KS, 0)>(vb + tile * 16384), b1h = tr_read<v_rd_off(1, KS, 1)>(vb + tile * 16384); \
        asm volatile("s_waitcnt lgkmcnt(0)" ::: "memory"); SBAR(); \
        acc[0] = __builtin_amdgcn_mfma_f32_32x32x16_bf16(af[tile * 4 + KS], PKLH(b0l, b0h), acc[0], 0, 0, 0); \
        acc[1] = __builtin_amdgcn_mfma_f32_32x32x16_bf16(af[tile * 4 + KS], PKLH(b1l, b1h), acc[1], 0, 0, 0); } while (0)
        GT_STEP(0); GT_STEP(1); GT_STEP(2); GT_STEP(3);
#undef GT_STEP
    }
#pragma unroll
    for (int r = 0; r < 16; ++r) { const int p = pb * 32 + crow(r, hi); const float bias = bs[g * 128 + p];
        const bf16_t* up = Z + (size_t)(rowbase + p) * 2048 + g * 128; bf16_t* gp = Gout + (size_t)(rowbase + p) * DM + g * 128;
#pragma unroll
        for (int t = 0; t < 2; ++t) { const int d = (2 * dh + t) * 32 + r32; gp[d] = (bf16_t)f2bf(bf2f(up[d]) * (acc[t][r] + bias)); } }
}


#ifdef NO_ATT
#define PH_ATT(...) do {} while (0)
#else
#define PH_ATT(...) __VA_ARGS__
#endif
#ifdef NO_RS
#define PH_RS(...) do {} while (0)
#else
#define PH_RS(...) __VA_ARGS__
#endif
#ifdef NO_RO
#define PH_RO(...) do {} while (0)
#else
#define PH_RO(...) __VA_ARGS__
#endif
#ifdef NO_GT
#define PH_GT(...) do {} while (0)
#else
#define PH_GT(...) __VA_ARGS__
#endif
#ifdef NO_PRO
#define PH_PRO(...) do {} while (0)
#else
#define PH_PRO(...) __VA_ARGS__
#endif
#ifdef NO_GEMM
#define PH_GEMM(...) do {} while (0)
#else
#define PH_GEMM(...) __VA_ARGS__
#endif

#ifndef DUPMASK
#define DUPMASK 0
#endif
#ifndef DUPSYNC
#define DUPSYNC 0
#endif
#ifndef DUPGATE
#define DUPGATE 0
#endif
#define GSYNC() do { xcd_barrier(bar); if (DUPSYNC) xcd_barrier(bar); } while (0)
#define REPS(id) ((((DUPMASK) >> (id)) & 1) ? 2 : 1)
#define XB_TMO      128
#define XB_XCNT(j)  (256  + 64 * (j))
#define XB_XSUB(j)  (1280 + 64 * (j))
#define XB_XGEN(j)  (2304 + 64 * (j))
#define XB_TOP      3328
#define XB_TOPGEN   3392
#define XCD_BAR_WORDS 3456
#define XB_SPIN_CAP (1u << 18)

__device__ __forceinline__ unsigned xb_ld(unsigned* p)              { return __hip_atomic_load(p, __ATOMIC_RELAXED, __HIP_MEMORY_SCOPE_AGENT); }
__device__ __forceinline__ unsigned xb_add(unsigned* p, unsigned v) { return __hip_atomic_fetch_add(p, v, __ATOMIC_RELAXED, __HIP_MEMORY_SCOPE_AGENT); }
__device__ __forceinline__ unsigned xb_xcc_id() { return (unsigned)__builtin_amdgcn_s_getreg((3 << 11) | 20) & 0xFu; }
#define XB_SPIN(cond, bar) do { unsigned _sp = 0; while (cond) { __builtin_amdgcn_s_sleep(1); \
    if ((++_sp & 255u) == 0u) { if (xb_ld(&(bar)[XB_TMO])) break; if (_sp > XB_SPIN_CAP) { atomicAdd(&(bar)[XB_TMO], 1u); break; } } } } while (0)

struct XcdBarrier {
    unsigned* bar; unsigned x;
    volatile __attribute__((address_space(3))) unsigned* st;
};

__device__ __forceinline__ XcdBarrier xcd_barrier_post(unsigned* bar, volatile __attribute__((address_space(3))) unsigned* st) {
    XcdBarrier b; b.bar = bar; b.x = xb_xcc_id(); b.st = st;
    if (threadIdx.x == 0) (void)xb_add(&bar[XB_XCNT(b.x)], 1u);
    return b;
}
__device__ __forceinline__ void xcd_barrier_complete(unsigned* bar, unsigned x, unsigned& nloc, unsigned& nx) {
    const unsigned G = gridDim.x * gridDim.y * gridDim.z;
    unsigned sum, cnt, mine, sp = 0u;
    for (;;) {
        sum = 0u; cnt = 0u; mine = 0u;
#pragma unroll
        for (unsigned j = 0; j < 16; ++j) { const unsigned c = xb_ld(&bar[XB_XCNT(j)]); sum += c; cnt += (c > 0u) ? 1u : 0u; mine = (j == x) ? c : mine; }
        if (sum == G) break;
        __builtin_amdgcn_s_sleep(1);
        if ((++sp & 255u) == 0u) { if (xb_ld(&bar[XB_TMO])) break; if (sp > XB_SPIN_CAP) { atomicAdd(&bar[XB_TMO], 1u); break; } }
    }
    nloc = mine > 0u ? mine : 1u; nx = cnt > 0u ? cnt : 1u;
}

__device__ __forceinline__ void xcd_barrier(const XcdBarrier& b) {
    asm volatile("s_waitcnt vmcnt(0)" ::: "memory");
    __syncthreads();
    if (threadIdx.x == 0) {
        unsigned* bar = b.bar;
        __builtin_amdgcn_s_waitcnt(0);
        unsigned nloc = b.st[0], nx = b.st[1];
        if (nloc == 0u) { xcd_barrier_complete(bar, b.x, nloc, nx); b.st[0] = nloc; b.st[1] = nx; }
        const unsigned old = xb_add(&bar[XB_XSUB(b.x)], 1u);
        const unsigned gen = old / nloc;
        if (old + 1u == (gen + 1u) * nloc) {
            __builtin_amdgcn_fence(__ATOMIC_RELEASE, "agent");
            asm volatile("s_waitcnt vmcnt(0)" ::: "memory");
            const unsigned og = xb_add(&bar[XB_TOP], 1u);
            const unsigned tg = og / nx;
            if (og + 1u == (tg + 1u) * nx) xb_add(&bar[XB_TOPGEN], 1u);
            else XB_SPIN(xb_ld(&bar[XB_TOPGEN]) == tg, bar);
            __builtin_amdgcn_fence(__ATOMIC_ACQUIRE, "agent");
            xb_add(&bar[XB_XGEN(b.x)], 1u);
            asm volatile("s_waitcnt vmcnt(0)" ::: "memory");
        } else {
            XB_SPIN(xb_ld(&bar[XB_XGEN(b.x)]) == gen, bar);
            __builtin_amdgcn_fence(__ATOMIC_ACQUIRE, "agent");
            asm volatile("s_waitcnt vmcnt(0)" ::: "memory");
        }
    }
    __syncthreads();
}

__global__ void __launch_bounds__(512, 2) mk_fwd(Args a) {
    extern __shared__ __attribute__((aligned(16))) unsigned char lds_raw[];
    cg::grid_group grid = cg::this_grid();
    char* lds = (char*)lds_raw;
    int tid_ = threadIdx.x; asm volatile("" : "+v"(tid_)); const int tid = tid_, lane = tid & 63, wave = __builtin_amdgcn_readfirstlane(tid >> 6);
    const int G = gridDim.x, bx = blockIdx.x;
    const int gw = bx * 8 + wave, NGW = G * 8;
    unsigned char* ws = a.ws;
    float* MOD = (float*)(ws + WS_MOD);
    const float* ropec = (const float*)(ws + WS_ROPE); const float* ropes = ropec + 2048 * 64;
    bf16_t* XN = (bf16_t*)(ws + WS_XN); bf16_t* BIG = (bf16_t*)(ws + WS_BIG); bf16_t* ST = (bf16_t*)(ws + WS_ST);
    float* XCTX = (float*)(ws + WS_XCTX); float* SSQ = (float*)(ws + WS_SSQ);
    PG8_LAS unsigned char* glds = (PG8_LAS unsigned char*)lds_raw;
    volatile __attribute__((address_space(3))) unsigned* bst = (volatile __attribute__((address_space(3))) unsigned*)(glds + 147392);
    if (threadIdx.x < 2) bst[threadIdx.x] = 0u;
    __syncthreads();
    XcdBarrier bar = xcd_barrier_post((unsigned*)ws + 4096, bst);

for (int rep = 0; rep < REPS(0); ++rep) {
    PH_PRO(prologue(a, lds, G));
    grid.sync();
}

#pragma unroll 1
    for (int l = 0; l < DEPTH; ++l) {
        const bool even = (l & 1) == 0; const int li = l >> 1;
        const int Mrows = (l == DEPTH - 1) ? RLAT : RTOT;
        const float* modl = MOD + (size_t)l * 33 * 6144;
        const float* xin_lat = (l == 0) ? a.x : a.out; const float* xin_ctx = (l == 0) ? a.ctx : XCTX;
for (int rep = 0; rep < REPS(1); ++rep) {
        norm_phase(xin_lat, xin_ctx, a.norm1_g + l * 1024, modl, 0, XN, Mrows, NGW);
        GSYNC();
}
        if (even) {
for (int rep = 0; rep < REPS(2); ++rep) {
            { pg8::Gemm g{XN, (const bf16_t*)(ws + WS_WABIN) + (size_t)li * 3072 * 1024, Mrows, NIN, DM}; pg8::StaticOrder S; S.init(Mrows, NIN, G, bx);
              pg8::EpiBf16<0> E{BIG, NIN, nullptr};
              PH_GEMM(pg8::gemm_phase<pg8::EpiBf16<0>, pg8::StaticOrder, true, true>(glds, g, S, E)); }
            GSYNC();
}
            ropenorm_phase(BIG, ropec, ropes, a.q_g + li * 128, a.k_g + li * 128, NGW);
            GSYNC();
            const float rd_f[1] = {0};
            (void)rd_f;
for (int rep = 0; rep < REPS(4); ++rep) {
            for (int u = bx; u < 1024 + 256 + 128; u += G) {
                if (u < 1024) {
                    const int rnd = u >> 8, v = u & 255, x = v & 7, y = v >> 3; const int grp = rnd * 16 + x * 2 + (y >> 4);
                    const int b = grp >> 1, kvh = grp & 1, h = kvh * 2 + ((y >> 3) & 1), qb = y & 7;
                    const bf16_t* Pl = BIG + (size_t)(b * 2048) * NIN; const bf16_t* Pc = BIG + (size_t)(RLAT + b * 256) * NIN;
                    PH_ATT(attn::body(Pl + (size_t)(qb * 256) * NIN + 2048 + h * 128, Pc + 2560 + kvh * 128, Pc + 2816 + kvh * 128, 256,
                               Pl + 2560 + kvh * 128, Pl + 2816 + kvh * 128, XN + (size_t)(b * 2048 + qb * 256) * DM + 512 + h * 128, 2304, lds));
                    __syncthreads();
                } else if (u < 1280) {
                    const int v = u - 1024, b = v >> 3, h = (v >> 1) & 3, dir = v & 1;
                    const float xd = a.ret_decay[(li * 2 + dir) * 4 + h]; const float lg2 = -log1pf(expf(-xd)) * 1.4426950408889634f;
                    PH_RS(ret_state_unit(BIG, ST, b, h, dir, lg2, lds));
                } else {
                    const int v = u - 1280, b = v >> 2, h = v & 3, kvh = h >> 1;
                    const bf16_t* Pc = BIG + (size_t)(RLAT + b * 256) * NIN;
                    PH_ATT(attn::body(Pc + 2048 + h * 128, Pc + 2560 + kvh * 128, Pc + 2816 + kvh * 128, 256, Pc, Pc, XN + (size_t)(RLAT + b * 256) * DM + 512 + h * 128, 256, lds));
                    __syncthreads();
                }
            }
            GSYNC();
}
for (int rep = 0; rep < REPS(5); ++rep) {
            for (int u = bx; u < 32 * 4 * 18; u += G) {
                const int cid = u % 18, bh = u / 18, b = bh >> 2, h = bh & 3;
                const float xf_ = a.ret_decay[(li * 2 + 0) * 4 + h], xb_ = a.ret_decay[(li * 2 + 1) * 4 + h];
                const float lgf = -log1pf(expf(-xf_)) * 1.4426950408889634f, lgb = -log1pf(expf(-xb_)) * 1.4426950408889634f;
                PH_RO(ret_out_unit(BIG, ST, XN, b, h, cid, lgf, lgb, lds));
            }
            __syncthreads();
            GSYNC();
}
            for (int rep = 0; rep < (DUPGATE ? 2 : 1); ++rep) { const bool dummy_ = DUPGATE && rep == 0;
{ pg8::Gemm g{XN, (const bf16_t*)(ws + WS_WABOUT) + (size_t)li * 1024 * 1024, Mrows, DM, DM}; pg8::StaticOrder S; S.init(Mrows, DM, G, bx);
              pg8::EpiGate E{dummy_, xin_lat, xin_ctx, a.out, XCTX, modl + 2048};
              PH_GEMM(pg8::gemm_phase<pg8::EpiGate, pg8::StaticOrder, true, true>(glds, g, S, E)); }
            GSYNC(); }
        } else {
for (int rep = 0; rep < REPS(7); ++rep) {
            { pg8::Gemm g{XN, (const bf16_t*)(ws + WS_WCMIN) + (size_t)li * 2048 * 1024, Mrows, 2048, DM}; pg8::StaticOrder S; S.init(Mrows, 2048, G, bx);
              pg8::EpiBf16<1> E{BIG, 2048, SSQ};
              PH_GEMM(pg8::gemm_phase<pg8::EpiBf16<1>, pg8::StaticOrder, true, true>(glds, g, S, E)); }
            GSYNC();
}
for (int rep = 0; rep < REPS(8); ++rep) {
            for (int u = bx; u < (Mrows / 128) * 8; u += G)
                PH_GT(gate_unit(BIG, SSQ, a.cm_v_g + li * 1024, (const bf16_t*)(ws + WS_WSB) + (size_t)li * 8 * 128 * 128, a.cm_b_s + li * 8 * 128, XN, u >> 3, u & 7, lds));
            __syncthreads();
            GSYNC();
}
            for (int rep = 0; rep < (DUPGATE ? 2 : 1); ++rep) { const bool dummy_ = DUPGATE && rep == 0;
{ pg8::Gemm g{XN, (const bf16_t*)(ws + WS_WCMOUT) + (size_t)li * 1024 * 1024, Mrows, DM, DM}; pg8::StaticOrder S; S.init(Mrows, DM, G, bx);
              pg8::EpiGate E{dummy_, xin_lat, xin_ctx, a.out, XCTX, modl + 2048};
              PH_GEMM(pg8::gemm_phase<pg8::EpiGate, pg8::StaticOrder, true, true>(glds, g, S, E)); }
            GSYNC(); }
        }
for (int rep = 0; rep < REPS(10); ++rep) {
        norm_phase(a.out, XCTX, a.norm2_g + l * 1024, modl, 1, XN, Mrows, NGW);
        GSYNC();
}
for (int rep = 0; rep < REPS(11); ++rep) {
        { pg8::Gemm g{XN, (const bf16_t*)(ws + WS_WFF1) + (size_t)l * 4096 * 1024, Mrows, FF, DM}; pg8::StaticOrder S; S.init(Mrows, FF, G, bx);
          pg8::EpiBf16<2> E{BIG, FF, nullptr};
          PH_GEMM(pg8::gemm_phase<pg8::EpiBf16<2>, pg8::StaticOrder, true, true>(glds, g, S, E)); }
        GSYNC();
}
        for (int rep = 0; rep < (DUPGATE ? 2 : 1); ++rep) { const bool dummy_ = DUPGATE && rep == 0;
{ pg8::Gemm g{BIG, (const bf16_t*)(ws + WS_WFF2) + (size_t)l * 1024 * 4096, Mrows, DM, FF}; pg8::StaticOrder S; S.init(Mrows, DM, G, bx);
          pg8::EpiGate E{dummy_, a.out, XCTX, a.out, XCTX, modl + 5 * 1024};
          PH_GEMM(pg8::gemm_phase<pg8::EpiGate, pg8::StaticOrder, true, true>(glds, g, S, E)); }
        GSYNC(); }
    }
}

extern "C" void kernel_launch(void* const* d_in, const int* in_sizes, int n_in, void* d_out, int out_size, void* d_ws, size_t ws_size, hipStream_t stream) {
    static int grid = 0;
    if (grid == 0) {
        if (n_in != 20 || out_size != RLAT * DM || ws_size < WS_END) { fprintf(stderr, "kernel_launch: unexpected shapes: n_in %d out %d ws %zu (need %zu)\n", n_in, out_size, ws_size, (size_t)WS_END); grid = -1; return; }
        int dev = 0, cus = 0, per_cu = 0;
        (void)hipGetDevice(&dev);
        (void)hipDeviceGetAttribute(&cus, hipDeviceAttributeMultiprocessorCount, dev);
        if (hipFuncSetAttribute((const void*)mk_fwd, hipFuncAttributeMaxDynamicSharedMemorySize, LDS_BYTES) != hipSuccess) { fprintf(stderr, "kernel_launch: hipFuncSetAttribute failed\n"); grid = -1; return; }
        (void)hipOccupancyMaxActiveBlocksPerMultiprocessor(&per_cu, (const void*)mk_fwd, 512, LDS_BYTES);
        if (per_cu < 1) { fprintf(stderr, "kernel_launch: occupancy query says %d blocks per CU\n", per_cu); per_cu = 1; }
        grid = cus * per_cu;
    }
    if (grid < 0) return;
    if (hipMemsetAsync(d_ws, 0, 65536, stream) != hipSuccess) { fprintf(stderr, "kernel_launch: memset failed\n"); return; }
    Args a{};
    a.x = (const float*)d_in[0]; a.c = (const float*)d_in[1]; a.ctx = (const float*)d_in[2]; a.c_ctx = (const float*)d_in[3]; a.mod_w = (const float*)d_in[4]; a.mod_b = (const float*)d_in[5];
    a.norm1_g = (const float*)d_in[6]; a.norm2_g = (const float*)d_in[7]; a.ab_w_in = (const float*)d_in[8]; a.ab_w_out = (const float*)d_in[9]; a.ret_decay = (const float*)d_in[10];
    a.q_g = (const float*)d_in[11]; a.k_g = (const float*)d_in[12]; a.cm_w_in = (const float*)d_in[13]; a.cm_v_g = (const float*)d_in[14]; a.cm_w_s = (const float*)d_in[15]; a.cm_b_s = (const float*)d_in[16];
    a.cm_w_out = (const float*)d_in[17]; a.ff_w1 = (const float*)d_in[18]; a.ff_w2 = (const float*)d_in[19];
    a.out = (float*)d_out; a.ws = (unsigned char*)d_ws; a.ph_lo = 0; a.ph_hi = 0;
    void* args[] = {&a};
    hipError_t e = hipLaunchCooperativeKernel((const void*)mk_fwd, dim3(grid), dim3(512), args, LDS_BYTES, stream);
    if (e != hipSuccess) fprintf(stderr, "kernel_launch: cooperative launch failed: %s (grid %d)\n", hipGetErrorString(e), grid);
}
```

```cpp
#include <hip/hip_runtime.h>
#include <hip/hip_cooperative_groups.h>
#include <cstdio>
#include <cstdint>
namespace cg = cooperative_groups;

namespace pg8 {
#define PG8_LAS __attribute__((address_space(3)))
typedef unsigned short bf16_t;
typedef short bf16x8 __attribute__((ext_vector_type(8)));
typedef float f32x4 __attribute__((ext_vector_type(4)));
typedef unsigned u32x4 __attribute__((ext_vector_type(4)));
constexpr int BM = 256, BK = 64, HALF = 128, HTB = HALF * BK * 2, STAGE_BYTES = 8 * HTB, NXCD = 8, WGM = 4;

__host__ __device__ __forceinline__ int lds_byte(int r, int c) { const int st = (r >> 4) * 2 + (c >> 5), rr = r & 15, cc = c & 31, ob = rr * 64 + cc * 2; return st * 1024 + (ob ^ (((ob >> 9) & 1) << 5)); }
__host__ __device__ __forceinline__ void stage_rc(int b, int& R, int& C) { const int st = b / 1024, sb = b % 1024, swz = sb ^ (((sb >> 9) & 1) << 5); R = (st >> 1) * 16 + swz / 64; C = (st & 1) * 32 + (swz % 64) / 2; }
__host__ __device__ __forceinline__ int perm32(int rho) { const int n = rho >> 4, i = rho & 15; return 8 * (i >> 2) + 4 * n + (i & 3); }

__device__ __forceinline__ int lane_id() { int l = (int)__builtin_amdgcn_mbcnt_hi(~0u, __builtin_amdgcn_mbcnt_lo(~0u, 0u)); asm volatile("" : "+v"(l)); return l; }
__device__ __forceinline__ float shx(float v, int k) { const int src = (lane_id() ^ k) << 2; return __int_as_float(__builtin_amdgcn_ds_bpermute(src, __float_as_int(v))); }
struct Unit { int pm, pn, par; };
struct Gemm { const bf16_t* A; const bf16_t* Bt; int M, N, K; };

struct StaticOrder {
    int nM, nN, nwg, G, c;
    __host__ __device__ void init(int M, int N, int G_, int c_) { nM = M / BM; nN = N / BM; nwg = nM * nN; G = G_; c = c_; }
    __host__ __device__ bool next(int i, Unit& u) const {
        const long L = (long)i * G + c; if (L >= nwg) return false;
        int wgid = (int)L; { const int q = nwg / NXCD, r = nwg % NXCD, xcd = wgid % NXCD, off = wgid / NXCD; wgid = (xcd < r ? xcd * (q + 1) : r * (q + 1) + (xcd - r) * q) + off; }
        const int nig = WGM * nN, gid = wgid / nig, fm = gid * WGM, gsz = (nM - fm) < WGM ? (nM - fm) : WGM;
        u.pm = fm + ((wgid % nig) % gsz); u.pn = (wgid % nig) / gsz; u.par = i & 1; return true;
    }
    __device__ __forceinline__ void a_ready(const Unit&) const {}
    __device__ __forceinline__ void done(const Unit&) const {}
};

constexpr int RINV_LDS_OFF = 131072 + 2048;
__device__ __forceinline__ unsigned lds_addr(PG8_LAS unsigned char* p) { return (unsigned)(__SIZE_TYPE__)p; }
__device__ __forceinline__ void lds_st_f32(unsigned addr, float v) { asm volatile("ds_write_b32 %0, %1" :: "v"(addr), "v"(v) : "memory"); }
__device__ __forceinline__ void lds_ld8_rows(unsigned addr, float (&r)[2][4]) {
    asm volatile("ds_read_b32 %0, %8\n\tds_read_b32 %1, %8 offset:64\n\tds_read_b32 %2, %8 offset:128\n\tds_read_b32 %3, %8 offset:192\n\t"
                 "ds_read_b32 %4, %8 offset:512\n\tds_read_b32 %5, %8 offset:576\n\tds_read_b32 %6, %8 offset:640\n\tds_read_b32 %7, %8 offset:704\n\ts_waitcnt lgkmcnt(0)"
                 : "=&v"(r[0][0]), "=&v"(r[0][1]), "=&v"(r[0][2]), "=&v"(r[0][3]), "=&v"(r[1][0]), "=&v"(r[1][1]), "=&v"(r[1][2]), "=&v"(r[1][3]) : "v"(addr) : "memory");
}
__device__ __forceinline__ void lds_ld4x4(unsigned addr, f32x4& a, f32x4& b, f32x4& c, f32x4& d, const int) {
    asm volatile("ds_read_b128 %0, %4\n\tds_read_b128 %1, %4 offset:16\n\tds_read_b128 %2, %4 offset:512\n\tds_read_b128 %3, %4 offset:528\n\ts_waitcnt lgkmcnt(0)"
                 : "=&v"(a), "=&v"(b), "=&v"(c), "=&v"(d) : "v"(addr) : "memory");
}
__device__ __forceinline__ void lds_ld4x4_f32(unsigned addr, f32x4& a, f32x4& b, f32x4& c, f32x4& d) {
    asm volatile("ds_read_b128 %0, %4\n\tds_read_b128 %1, %4 offset:64\n\tds_read_b128 %2, %4 offset:512\n\tds_read_b128 %3, %4 offset:576\n\ts_waitcnt lgkmcnt(0)"
                 : "=&v"(a), "=&v"(b), "=&v"(c), "=&v"(d) : "v"(addr) : "memory");
}
constexpr int CV_LDS_OFF = RINV_LDS_OFF + 2048;
struct RinvPf { f32x4 a, b; float c0, c1, c2; };
struct NormOrder : StaticOrder {
    const float* ssq; PG8_LAS unsigned char* lds; bool on; int wv; const float* dummy;
    int ctx_live = 0;
    __host__ __device__ bool next(int i, Unit& u) const {
        if (!ctx_live) return StaticOrder::next(i, u);
        const long L = (long)i * G + c;
        if (L < nwg) return StaticOrder::next(i, u);
        const long Lc = L - nwg; if (Lc >= (long)ctx_live * 6) return false;
        const int j = (int)(Lc % 6); u.pm = nM + (int)(Lc / 6); u.pn = j < 4 ? 2 + j : 6 + j; u.par = i & 1; return true;
    }
    const float* v0; int ld0; const float* v1; const float* v2; int ld2;
    __device__ __forceinline__ RinvPf prefetch(const Unit& u, bool has) const {
        RinvPf r; const int t = (wv << 6) | lane_id();
        const bool colt = t >= 256; const int bidx = u.pm < 256 ? (u.pm >> 3) : 32; const int col = u.pn * BM + (t & 255);
        const float* pa = (has && on) ? ssq + (size_t)(u.pm * BM + (t >> 1)) * 16 + (t & 1) * 8 : dummy;
        const float* p0 = (has && colt && v0) ? v0 + (size_t)bidx * ld0 + col : dummy;
        const float* p1 = (has && colt && v1) ? v1 + col : dummy;
        const float* p2 = (has && colt && v1) ? v2 + (size_t)bidx * ld2 + col : dummy;
        const f32x4* p = (const f32x4*)pa; r.a = p[0]; r.b = p[1];
        r.c0 = *p0; r.c1 = *p1; r.c2 = *p2;
        return r;
    }
    __device__ __forceinline__ void commit(const Unit& u, bool has, const RinvPf& r) const {
        const int t = (wv << 6) | lane_id();
        float s = ((r.a[0] + r.a[1]) + (r.a[2] + r.a[3])) + ((r.b[0] + r.b[1]) + (r.b[2] + r.b[3]));
        s += shx(s, 1);
        const float rinv = 1.0f / sqrtf(fabsf(s) * (1.0f / 1024.0f) + 1e-6f); const float gsv = r.c1 * (1.0f + r.c2);
        if (has) {
            if (on && (t & 1) == 0) lds_st_f32(lds_addr(lds) + RINV_LDS_OFF + (u.par * 256 + (t >> 1)) * 4, rinv);
            if (t >= 256) { const unsigned ca = lds_addr(lds) + CV_LDS_OFF + (u.par * 768 + (t - 256)) * 4; lds_st_f32(ca, r.c0); lds_st_f32(ca + 1024, gsv); }
        }
    }
    __device__ __forceinline__ void a_ready(const Unit& u) const { const RinvPf r = prefetch(u, true); commit(u, true, r); }
};
__device__ __forceinline__ unsigned cvt_pk_bf16(float lo, float hi) { unsigned r; asm volatile("v_cvt_pk_bf16_f32 %0, %1, %2" : "=v"(r) : "v"(lo), "v"(hi)); return r; }
__device__ __forceinline__ float gelu_tanh(float x) {
    const float u = 0.7978845608f * (x + 0.044715f * x * x * x);
    const float e = __builtin_amdgcn_exp2f(-2.885390082f * u);
    return x * __builtin_amdgcn_rcpf(1.0f + e);
}
constexpr int RLAT_ROWS = 65536;
template <int ACT> struct EpiBf16 {
    static constexpr bool PERM = true, AFTER_DRAIN = false;
    bf16_t* O; int ldc; float* ssq; bool nrm; PG8_LAS unsigned char* lds;
    __device__ __forceinline__ void operator()(const f32x4 (&acc)[2][2][4][2], const Unit& u, int wr, int wc, int fr_in, int fq) const {
        int fr = fr_in; asm volatile("" : "+v"(fr));
        const int row0 = u.pm * BM + wr * 64 + fr; const int col0 = u.pn * BM + wc * 32 + 8 * fq;
        const bool dossq = (ACT == 1) && (u.pn >= 4);
        f32x4 sv[2][2]; float rvt[2][4];
        if (nrm) { lds_ld4x4(lds_addr(lds) + CV_LDS_OFF + (u.par * 768 + wc * 32 + 8 * fq) * 4, sv[0][0], sv[0][1], sv[1][0], sv[1][1], 0);
                   lds_ld8_rows(lds_addr(lds) + RINV_LDS_OFF + (u.par * 256 + wr * 64 + fr) * 4, rvt); }
        else {
#pragma unroll
            for (int i = 0; i < 2; ++i) { sv[i][0] = (f32x4){0.f, 0.f, 0.f, 0.f}; sv[i][1] = (f32x4){0.f, 0.f, 0.f, 0.f};
#pragma unroll
                for (int j = 0; j < 4; ++j) rvt[i][j] = 1.0f; } }
#pragma unroll
        for (int ai = 0; ai < 2; ++ai)
#pragma unroll
            for (int m = 0; m < 4; ++m) { bf16_t* rowp = O + (size_t)(row0 + ai * HALF + m * 16) * ldc + col0; float ss = 0.f; const float rv = rvt[ai][m];
#pragma unroll
                for (int bj = 0; bj < 2; ++bj) { f32x4 v0 = acc[ai][bj][m][0] * rv + sv[bj][0], v1 = acc[ai][bj][m][1] * rv + sv[bj][1];
                    if (ACT == 1) {
#pragma unroll
                        for (int e = 0; e < 4; ++e) { v0[e] = gelu_tanh(v0[e]); v1[e] = gelu_tanh(v1[e]); }
                        ss += (v0[0] * v0[0] + v0[1] * v0[1]) + (v0[2] * v0[2] + v0[3] * v0[3]) + (v1[0] * v1[0] + v1[1] * v1[1]) + (v1[2] * v1[2] + v1[3] * v1[3]);
                    }
                    if (ACT == 2) {
#pragma unroll
                        for (int e = 0; e < 4; ++e) { const float a = fmaxf(v0[e], 0.f), b = fmaxf(v1[e], 0.f); v0[e] = a * a; v1[e] = b * b; }
                    }
                    u32x4 w; w.x = cvt_pk_bf16(v0[0], v0[1]); w.y = cvt_pk_bf16(v0[2], v0[3]); w.z = cvt_pk_bf16(v1[0], v1[1]); w.w = cvt_pk_bf16(v1[2], v1[3]);
                    *(u32x4*)(rowp + bj * HALF) = w; }
                if (ACT == 1) { if (dossq) { ss += shx(ss, 16); ss += shx(ss, 32);
                    if (fq == 0) ssq[(size_t)(row0 + ai * HALF + m * 16) * 16 + (u.pn - 4) * 4 + wc] = ss; } }
            }
    }
};

__host__ __device__ __forceinline__ int inproj_orig_col(int n) {
    const bool perm = (n < 1024) || (n >= 2048 && n < 2816);
    if (!perm) return n;
    const int p = n & 127, j = p >> 3, e = p & 7;
    return (n & ~127) + ((e < 4) ? 4 * j + e : 64 + 4 * j + (e - 4));
}
constexpr int QKN_LDS_OFF = CV_LDS_OFF + 6144;
struct EpiInProj {
    static constexpr bool PERM = true, AFTER_DRAIN = false;
    bf16_t* O; bool nrm; PG8_LAS unsigned char* lds; const float* ropec; const float* ropes; const float* qg; const float* kg;
    __device__ __forceinline__ void operator()(const f32x4 (&acc)[2][2][4][2], const Unit& u, int wr, int wc, int fr_in, int fq) const {
        int fr = fr_in; asm volatile("" : "+v"(fr));
        constexpr int ldc = 3072;
        const int row0 = u.pm * BM + wr * 64 + fr; const int col0 = u.pn * BM + wc * 32 + 8 * fq;
        const int kind = u.pn < 2 ? 0 : (u.pn < 4 ? 1 : ((u.pn < 8 || u.pn == 11) ? 2 : (u.pn < 10 ? 3 : 4)));
        const bool lat = u.pm < 256;
        f32x4 sv[2][2]; float rvt[2][4];
        if (nrm) { lds_ld4x4(lds_addr(lds) + CV_LDS_OFF + (u.par * 768 + wc * 32 + 8 * fq) * 4, sv[0][0], sv[0][1], sv[1][0], sv[1][1], 0);
                   lds_ld8_rows(lds_addr(lds) + RINV_LDS_OFF + (u.par * 256 + wr * 64 + fr) * 4, rvt); }
        else {
#pragma unroll
            for (int i = 0; i < 2; ++i) { sv[i][0] = (f32x4){0.f, 0.f, 0.f, 0.f}; sv[i][1] = (f32x4){0.f, 0.f, 0.f, 0.f};
#pragma unroll
                for (int j = 0; j < 4; ++j) rvt[i][j] = 1.0f; } }
        if (kind == 2) {
#pragma unroll
            for (int ai = 0; ai < 2; ++ai)
#pragma unroll
                for (int m = 0; m < 4; ++m) { bf16_t* rowp = O + (size_t)(row0 + ai * HALF + m * 16) * ldc + col0; const float rv = rvt[ai][m];
#pragma unroll
                    for (int bj = 0; bj < 2; ++bj) { const f32x4 v0 = acc[ai][bj][m][0] * rv + sv[bj][0], v1 = acc[ai][bj][m][1] * rv + sv[bj][1];
                        u32x4 w; w.x = cvt_pk_bf16(v0[0], v0[1]); w.y = cvt_pk_bf16(v0[2], v0[3]); w.z = cvt_pk_bf16(v1[0], v1[1]); w.w = cvt_pk_bf16(v1[2], v1[3]);
                        *(u32x4*)(rowp + bj * HALF) = w; } }
            return;
        }
        const int j16 = 4 * wc + fq;
        const bool qkn = kind >= 3;
        f32x4 g0 = (f32x4){1.f, 1.f, 1.f, 1.f}, g1 = g0;
        if (qkn) { const float* g = kind == 3 ? qg : kg; g0 = *(const f32x4*)(g + 4 * j16); g1 = *(const f32x4*)(g + 64 + 4 * j16); }
        const float mul = kind == 1 ? 0.088388347648318440f : 1.0f;
        const unsigned pbase = lds_addr(lds) + QKN_LDS_OFF;
#pragma unroll
        for (int ai = 0; ai < 2; ++ai) {
            float rn[4][2];
#pragma unroll
            for (int m = 0; m < 4; ++m) { rn[m][0] = 1.0f; rn[m][1] = 1.0f; }
            if (qkn) {
#pragma unroll
                for (int m = 0; m < 4; ++m)
#pragma unroll
                    for (int bj = 0; bj < 2; ++bj) { const f32x4 v0 = acc[ai][bj][m][0] * rvt[ai][m] + sv[bj][0], v1 = acc[ai][bj][m][1] * rvt[ai][m] + sv[bj][1];
                        float ss = (v0[0] * v0[0] + v0[1] * v0[1]) + (v0[2] * v0[2] + v0[3] * v0[3]) + (v1[0] * v1[0] + v1[1] * v1[1]) + (v1[2] * v1[2] + v1[3] * v1[3]);
                        ss += shx(ss, 16); ss += shx(ss, 32);
                        if (fq == 0) lds_st_f32(pbase + (((wr * 64 + m * 16 + fr) * 2 + bj) * 4 + wc) * 4, ss); }
                asm volatile("s_waitcnt lgkmcnt(0)" ::: "memory"); __builtin_amdgcn_s_barrier(); asm volatile("" ::: "memory");
#pragma unroll
                for (int m = 0; m < 4; ++m)
#pragma unroll
                    for (int bj = 0; bj < 2; ++bj) { f32x4 pp; asm volatile("ds_read_b128 %0, %1\n\ts_waitcnt lgkmcnt(0)" : "=&v"(pp) : "v"(pbase + (((wr * 64 + m * 16 + fr) * 2 + bj) * 4) * 4) : "memory");
                        rn[m][bj] = 1.0f / sqrtf(((pp[0] + pp[1]) + (pp[2] + pp[3])) * (1.0f / 128.0f) + 1e-6f); }
                asm volatile("s_waitcnt lgkmcnt(0)" ::: "memory"); __builtin_amdgcn_s_barrier(); asm volatile("" ::: "memory");
            }
#pragma unroll
            for (int m2 = 0; m2 < 4; m2 += 2) {
            f32x4 cs4[2], sn4[2];
#pragma unroll
            for (int mm = 0; mm < 2; ++mm) { cs4[mm] = (f32x4){1.f, 1.f, 1.f, 1.f}; sn4[mm] = (f32x4){0.f, 0.f, 0.f, 0.f};
                if (lat) { const int t = (row0 + ai * HALF + (m2 + mm) * 16) & 2047; cs4[mm] = *(const f32x4*)(ropec + t * 64 + 4 * j16); sn4[mm] = *(const f32x4*)(ropes + t * 64 + 4 * j16); } }
#pragma unroll
            for (int mm = 0; mm < 2; ++mm) { const int m = m2 + mm; const int row = row0 + ai * HALF + m * 16; bf16_t* rowp = O + (size_t)row * ldc + col0; const float rv = rvt[ai][m];
                const f32x4 cs = cs4[mm], sn = sn4[mm];
#pragma unroll
                for (int bj = 0; bj < 2; ++bj) { const float sc_ = rn[m][bj] * mul;
                    const f32x4 v0 = (acc[ai][bj][m][0] * rv + sv[bj][0]) * (g0 * sc_), v1 = (acc[ai][bj][m][1] * rv + sv[bj][1]) * (g1 * sc_);
                    const f32x4 o0 = v0 * cs - v1 * sn, o1 = v0 * sn + v1 * cs;
                    u32x4 w; w.x = cvt_pk_bf16(o0[0], o0[1]); w.y = cvt_pk_bf16(o0[2], o0[3]); w.z = cvt_pk_bf16(o1[0], o1[1]); w.w = cvt_pk_bf16(o1[2], o1[3]);
                    *(u32x4*)(rowp + bj * HALF) = w; } }
            }
        }
    }
};
struct EpiGate {
    static constexpr bool PERM = false, AFTER_DRAIN = false;
    bool dummy; const float* xin_lat; const float* xin_ctx; float* xout_lat; float* xout_ctx; PG8_LAS unsigned char* lds;
    bool nxt; bf16_t* xs; float* ssq;
    __device__ __forceinline__ void operator()(const f32x4 (&acc)[2][2][4][2], const Unit& u, int wr, int wc, int fr_in, int fq) const {
        int fr = fr_in; asm volatile("" : "+v"(fr));
        const bool lat = u.pm < 256; const int bidx = lat ? (u.pm >> 3) : 32;
        const float* xi = lat ? xin_lat + (size_t)u.pm * BM * 1024 : xin_ctx + (size_t)(u.pm - 256) * BM * 1024;
        float* xo = dummy ? xout_ctx + (size_t)(756u << 18) + (size_t)(u.pm & 31) * BM * 1024 : (lat ? xout_lat + (size_t)u.pm * BM * 1024 : xout_ctx + (size_t)(u.pm - 256) * BM * 1024);
        const int col0 = u.pn * BM + wc * 32 + 4 * fq;
        f32x4 gv[2][2], gs[2][2];
        { const unsigned ca = lds_addr(lds) + CV_LDS_OFF + (u.par * 768 + wc * 32 + 4 * fq) * 4;
          lds_ld4x4_f32(ca, gv[0][0], gv[0][1], gv[1][0], gv[1][1]); lds_ld4x4_f32(ca + 1024, gs[0][0], gs[0][1], gs[1][0], gs[1][1]); }
        typedef unsigned u32x2 __attribute__((ext_vector_type(2)));
#pragma unroll
        for (int ai = 0; ai < 2; ++ai)
#pragma unroll
            for (int m = 0; m < 4; ++m) { const int rloc = wr * 64 + fr + ai * HALF + m * 16; const size_t off = (size_t)rloc * 1024 + col0; float ss = 0.f;
                bf16_t* xsp = xs + (size_t)(u.pm * BM + rloc) * 1024 + col0;
#pragma unroll
                for (int bj = 0; bj < 2; ++bj)
#pragma unroll
                    for (int n = 0; n < 2; ++n) { const f32x4 xv = *(const f32x4*)(xi + off + bj * HALF + n * 16);
                        const f32x4 o = xv + gv[bj][n] * acc[ai][bj][m][n];
                        *(f32x4*)(xo + off + bj * HALF + n * 16) = o;
                        if (nxt) { ss += (o[0] * o[0] + o[1] * o[1]) + (o[2] * o[2] + o[3] * o[3]); const f32x4 y = o * gs[bj][n];
                            u32x2 w; w.x = cvt_pk_bf16(y[0], y[1]); w.y = cvt_pk_bf16(y[2], y[3]); *(u32x2*)(xsp + bj * HALF + n * 16) = w; } }
                if (nxt) { ss += shx(ss, 16); ss += shx(ss, 32); if (fq == 0) ssq[(size_t)(u.pm * BM + rloc) * 16 + u.pn * 4 + wc] = ss; }
                if (m == 3) asm volatile("" ::: "memory"); }
    }
};

template <class Epi, class Sched, bool ALIGN_EPI = false, bool SP2 = false>
__device__ __forceinline__ void gemm_phase(PG8_LAS unsigned char* lds, const Gemm g, const Sched& S, const Epi& E) {
    int tid_ = (S.wv << 6) | lane_id(); asm volatile("" : "+v"(tid_));
    const int tid = tid_, wid = __builtin_amdgcn_readfirstlane(tid >> 6), lane = tid & 63, wr = wid >> 2, wc = wid & 3, fr = lane & 15, fq = lane >> 4;
    const int K = g.K, nt = K / BK;
#ifdef GEMM_STAGGER
    { const unsigned grp = (blockIdx.x >> 3) & 3u;
      if (grp) { const unsigned long long t0 = __builtin_amdgcn_s_memrealtime(); while (__builtin_amdgcn_s_memrealtime() - t0 < (unsigned long long)(grp * GEMM_STAGGER)) __builtin_amdgcn_s_sleep(16); } }
#endif
    unsigned voffA[2], voffB[2];
#pragma unroll
    for (int i = 0; i < 2; ++i) { int R, C; stage_rc(tid * 16 + i * 8192, R, C); const int Rb = Epi::PERM ? ((R & ~31) + perm32(R & 31)) : R;
        voffA[i] = (unsigned)(R * K + C) * 2u; voffB[i] = (unsigned)(Rb * K + C) * 2u; }
    const size_t kstep = (size_t)(BK * 2);
    const size_t hstep = (size_t)HALF * K * 2;
    const size_t tstep = 2 * hstep;
    const unsigned ldsw = (unsigned)wid * 1024u;
    const int aoff = lds_byte(wr * 64 + fr, fq * 8), boff = lds_byte(wc * 32 + fr, fq * 8);
#define PG8_SA(b, h) (((b) * 2 + (h)) * HTB)
#define PG8_SB(b, h) ((4 + (b) * 2 + (h)) * HTB)
#define PG8_STAGE(bufoff, gbase, voff) do { _Pragma("unroll") for (int _i = 0; _i < 2; ++_i) \
        __builtin_amdgcn_global_load_lds((const unsigned*)((const char*)(gbase) + (voff)[_i]), (PG8_LAS unsigned*)(lds + (bufoff) + ldsw + _i * 8192), 16, 0, 0); } while (0)
#define PG8_LDA(dst, b, h) do { _Pragma("unroll") for (int m = 0; m < 4; ++m) _Pragma("unroll") for (int k = 0; k < 2; ++k) dst[m][k] = *(const PG8_LAS bf16x8*)(lds + PG8_SA(b, h) + aoff + m * 2048 + k * 1024); } while (0)
#define PG8_LDB(dst, b, h) do { _Pragma("unroll") for (int n = 0; n < 2; ++n) _Pragma("unroll") for (int k = 0; k < 2; ++k) dst[n][k] = *(const PG8_LAS bf16x8*)(lds + PG8_SB(b, h) + boff + n * 2048 + k * 1024); } while (0)
#define PG8_MMA(ai, bj, At, Bt) do { __builtin_amdgcn_s_setprio(1); _Pragma("unroll") for (int m = 0; m < 4; ++m) _Pragma("unroll") for (int n = 0; n < 2; ++n) _Pragma("unroll") for (int k = 0; k < 2; ++k) \
        acc[ai][bj][m][n] = __builtin_amdgcn_mfma_f32_16x16x32_bf16(Bt[n][k], At[m][k], acc[ai][bj][m][n], 0, 0, 0); __builtin_amdgcn_s_setprio(0); } while (0)
#define PG8_WAIT_V(n) asm volatile("s_waitcnt vmcnt(" #n ")" ::: "memory")
#define PG8_WAIT_L(n) asm volatile("s_waitcnt lgkmcnt(" #n ")" ::: "memory")
#define PG8_BAR __builtin_amdgcn_s_barrier()
#define PG8_SCHED __builtin_amdgcn_sched_barrier(0)
    Unit cur, nxt; int ui = 0;
    if (!S.next(0, cur)) return;
    f32x4 acc[2][2][4][2];
#pragma unroll
    for (int a = 0; a < 2; ++a)
#pragma unroll
        for (int b = 0; b < 2; ++b)
#pragma unroll
            for (int m = 0; m < 4; ++m)
#pragma unroll
                for (int n = 0; n < 2; ++n) acc[a][b][m][n] = (f32x4){0.f, 0.f, 0.f, 0.f};
    bf16x8 At[4][2], B0[2][2], B1[2][2];
    const char* cA = (const char*)g.A + (size_t)cur.pm * tstep; const char* cB = (const char*)g.Bt + (size_t)cur.pn * tstep;
    S.a_ready(cur);
    auto pf_ = S.prefetch(cur, false);
    if constexpr (SP2) {
        PG8_STAGE(PG8_SB(0, 0), cB, voffB); PG8_STAGE(PG8_SB(0, 1), cB + hstep, voffB); PG8_STAGE(PG8_SA(0, 0), cA, voffA); PG8_STAGE(PG8_SA(0, 1), cA + hstep, voffA);
        if (wr == 1) PG8_BAR;
        PG8_WAIT_V(2); PG8_BAR;
        PG8_STAGE(PG8_SB(1, 0), cB + kstep, voffB); PG8_STAGE(PG8_SA(1, 0), cA + kstep, voffA); PG8_STAGE(PG8_SB(1, 1), cB + hstep + kstep, voffB);
        PG8_WAIT_V(6); PG8_BAR;
    } else {
        PG8_STAGE(PG8_SB(0, 0), cB, voffB); PG8_STAGE(PG8_SA(0, 0), cA, voffA); PG8_STAGE(PG8_SB(0, 1), cB + hstep, voffB); PG8_STAGE(PG8_SA(0, 1), cA + hstep, voffA);
        if (wr == 1) PG8_BAR;
        PG8_WAIT_V(4); PG8_BAR;
        PG8_STAGE(PG8_SB(1, 0), cB + kstep, voffB); PG8_STAGE(PG8_SA(1, 0), cA + kstep, voffA); PG8_STAGE(PG8_SB(1, 1), cB + hstep + kstep, voffB);
        PG8_WAIT_V(6); PG8_BAR;
    }
    for (;;) {
        const bool has_next = S.next(ui + 1, nxt);
        const char* nA = has_next ? (const char*)g.A + (size_t)nxt.pm * tstep : cA; const char* nB = has_next ? (const char*)g.Bt + (size_t)nxt.pn * tstep : cB;
        for (int t = 0; t < nt; t += 2) {
            const bool last = (t == nt - 2);
            if (last) pf_ = S.prefetch(nxt, has_next);
            const char* a1 = cA + (size_t)(t + 1) * kstep;
            const char* a2 = last ? nA : cA + (size_t)(t + 2) * kstep; const char* b2 = last ? nB : cB + (size_t)(t + 2) * kstep;
            const char* a3 = a2 + kstep; const char* b3 = b2 + kstep;
            if constexpr (SP2) {
            PG8_LDB(B0, 0, 0); PG8_LDB(B1, 0, 1); PG8_SCHED; PG8_LDA(At, 0, 0); PG8_STAGE(PG8_SA(1, 1), a1 + hstep, voffA);
            PG8_WAIT_V(8); PG8_WAIT_L(0); PG8_BAR; PG8_MMA(0, 0, At, B0); PG8_MMA(0, 1, At, B1); PG8_BAR; PG8_SCHED;
            PG8_LDA(At, 0, 1); PG8_STAGE(PG8_SB(0, 0), b2, voffB); PG8_STAGE(PG8_SB(0, 1), b2 + hstep, voffB); PG8_STAGE(PG8_SA(0, 0), a2, voffA);
            PG8_WAIT_V(8); PG8_WAIT_L(0); PG8_BAR; PG8_MMA(1, 0, At, B0); PG8_MMA(1, 1, At, B1); PG8_BAR; PG8_SCHED;
            PG8_LDB(B0, 1, 0); PG8_LDB(B1, 1, 1); PG8_SCHED; PG8_LDA(At, 1, 0); PG8_STAGE(PG8_SA(0, 1), a2 + hstep, voffA);
            PG8_WAIT_V(8); PG8_WAIT_L(0); PG8_BAR; PG8_MMA(0, 0, At, B0); PG8_MMA(0, 1, At, B1); PG8_BAR; PG8_SCHED;
            PG8_LDA(At, 1, 1); PG8_STAGE(PG8_SB(1, 0), b3, voffB); PG8_STAGE(PG8_SB(1, 1), b3 + hstep, voffB); PG8_STAGE(PG8_SA(1, 0), a3, voffA);
            PG8_WAIT_V(8); PG8_WAIT_L(0); PG8_BAR; PG8_MMA(1, 0, At, B0); PG8_MMA(1, 1, At, B1); PG8_BAR; PG8_SCHED;
            } else {
            PG8_LDB(B0, 0, 0); PG8_SCHED; PG8_LDA(At, 0, 0); PG8_STAGE(PG8_SA(1, 1), a1 + hstep, voffA);
            PG8_WAIT_L(8); PG8_BAR; PG8_WAIT_L(0); PG8_MMA(0, 0, At, B0); PG8_BAR; PG8_SCHED;
            PG8_LDB(B1, 0, 1); PG8_STAGE(PG8_SB(0, 0), b2, voffB);
            PG8_BAR; PG8_WAIT_L(0); PG8_MMA(0, 1, At, B1); PG8_BAR;
            PG8_LDA(At, 0, 1); PG8_STAGE(PG8_SA(0, 0), a2, voffA);
            PG8_BAR; PG8_WAIT_L(0); PG8_MMA(1, 0, At, B0); PG8_BAR; PG8_SCHED;
            PG8_STAGE(PG8_SB(0, 1), b2 + hstep, voffB);
            PG8_WAIT_V(6); PG8_BAR; PG8_MMA(1, 1, At, B1); PG8_BAR;
            PG8_LDB(B0, 1, 0); PG8_SCHED; PG8_LDA(At, 1, 0); PG8_STAGE(PG8_SA(0, 1), a2 + hstep, voffA);
            PG8_WAIT_L(8); PG8_BAR; PG8_WAIT_L(0); PG8_MMA(0, 0, At, B0); PG8_BAR; PG8_SCHED;
            PG8_LDB(B1, 1, 1); PG8_STAGE(PG8_SB(1, 0), b3, voffB);
            PG8_BAR; PG8_WAIT_L(0); PG8_MMA(0, 1, At, B1); PG8_BAR;
            PG8_LDA(At, 1, 1); PG8_STAGE(PG8_SA(1, 0), a3, voffA);
            PG8_BAR; PG8_WAIT_L(0); PG8_MMA(1, 0, At, B0); PG8_BAR; PG8_SCHED;
            PG8_STAGE(PG8_SB(1, 1), b3 + hstep, voffB);
            PG8_WAIT_V(6); PG8_BAR; PG8_MMA(1, 1, At, B1); PG8_BAR;
            }
        }
        if constexpr (ALIGN_EPI) { if (wr == 0) PG8_BAR; }
        if constexpr (!Epi::AFTER_DRAIN) { S.commit(nxt, has_next, pf_); E(acc, cur, wr, wc, fr, fq); S.done(cur); }
        if (!has_next) break;
#pragma unroll
        for (int a = 0; a < 2; ++a)
#pragma unroll
            for (int b = 0; b < 2; ++b)
#pragma unroll
                for (int m = 0; m < 4; ++m)
#pragma unroll
                    for (int n = 0; n < 2; ++n) acc[a][b][m][n] = (f32x4){0.f, 0.f, 0.f, 0.f};
        cur = nxt; cA = nA; cB = nB; ++ui;
        if constexpr (ALIGN_EPI) { if (wr == 1) PG8_BAR; }
    }
    PG8_WAIT_V(0);
    if constexpr (!ALIGN_EPI) { if (wr == 0) PG8_BAR; }
    PG8_BAR;
    if constexpr (Epi::AFTER_DRAIN) { E.fused(acc, cur, wr, wc, fr, fq, lds, wid, lane); S.done(cur); }
#ifdef GEMM_IDLE_TAIL
    { const unsigned long long t0 = __builtin_amdgcn_s_memrealtime(); while (__builtin_amdgcn_s_memrealtime() - t0 < (unsigned long long)(GEMM_IDLE_TAIL)) __builtin_amdgcn_s_sleep(32); }
#endif
#undef PG8_SA
#undef PG8_SB
#undef PG8_STAGE
#undef PG8_LDA
#undef PG8_LDB
#undef PG8_MMA
#undef PG8_WAIT_V
#undef PG8_WAIT_L
#undef PG8_BAR
#undef PG8_SCHED
}}

typedef unsigned short bf16_t;
typedef float f32x4 __attribute__((ext_vector_type(4)));
typedef unsigned u32x4 __attribute__((ext_vector_type(4)));
typedef unsigned u32x2 __attribute__((ext_vector_type(2)));
using bf16x8 = __attribute__((ext_vector_type(8))) short;
using s16x4  = __attribute__((ext_vector_type(4))) short;
using f32x16 = __attribute__((ext_vector_type(16))) float;

constexpr int DM = 1024, NB = 32, SEQ = 2048, CTXL = 256, DEPTH = 4, NIN = 3072, FF = 4096;
constexpr int RLAT = NB * SEQ, RCTX = NB * CTXL, RTOT = RLAT + RCTX;
constexpr float EPS = 1e-6f;
constexpr size_t MiB = 1u << 20;
constexpr size_t WS_MOD = 1 * MiB;
constexpr size_t WS_ROPE = 5 * MiB;
constexpr size_t WS_WSB = 6 * MiB;
constexpr size_t WS_SSQ = 7 * MiB;
constexpr size_t WS_WABIN = 12 * MiB;
constexpr size_t WS_WABOUT = 24 * MiB;
constexpr size_t WS_WCMIN = 28 * MiB;
constexpr size_t WS_WCMOUT = 36 * MiB;
constexpr size_t WS_WFF1 = 40 * MiB;
constexpr size_t WS_WFF2 = 72 * MiB;
constexpr size_t WS_XCTX = 104 * MiB;
constexpr size_t WS_XN = 136 * MiB;
constexpr size_t WS_BIG = 280 * MiB;
constexpr size_t WS_ST = WS_BIG + 432 * MiB;
constexpr size_t WS_XS = 856 * MiB;
constexpr size_t WS_SSQA = 1000 * MiB;
constexpr size_t WS_SSQB = 1005 * MiB;
constexpr size_t WS_SHW = 1010 * MiB;
constexpr size_t WS_END = 1015 * MiB;
constexpr int LDS_BYTES = 147456;

__device__ __forceinline__ float bf2f(bf16_t v) { return __uint_as_float((unsigned)v << 16); }
__device__ __forceinline__ unsigned f2bf(float f) { unsigned u = __float_as_uint(f); return (u + 0x7fffu + ((u >> 16) & 1u)) >> 16; }
__device__ __forceinline__ unsigned cvtpk(float lo, float hi) { unsigned r; asm volatile("v_cvt_pk_bf16_f32 %0, %1, %2" : "=v"(r) : "v"(lo), "v"(hi)); return r; }
__device__ __forceinline__ int lane_id() { int l = (int)__builtin_amdgcn_mbcnt_hi(~0u, __builtin_amdgcn_mbcnt_lo(~0u, 0u)); asm volatile("" : "+v"(l)); return l; }
__device__ __forceinline__ float shx(float v, int k) { const int src = (lane_id() ^ k) << 2; return __int_as_float(__builtin_amdgcn_ds_bpermute(src, __float_as_int(v))); }
__device__ __forceinline__ float wave_sum(float v) {
#pragma unroll
    for (int o = 1; o < 64; o <<= 1) v += shx(v, o);
    return v;
}
#define LDS_WAIT() asm volatile("s_waitcnt lgkmcnt(0)" ::: "memory")
#define SBAR() __builtin_amdgcn_sched_barrier(0)
#define KSWZ(row, colB) ((row) * 256 + ((colB) ^ (((row) & 7) << 4)))
__device__ __forceinline__ int crow(int r, int hi) { return (r & 3) + 8 * (r >> 2) + 4 * hi; }

__device__ __forceinline__ int v_st(int k, int c) { const int kk = (k & ~0xC) | ((k & 4) << 1) | ((k & 8) >> 1); return ((kk >> 3) * 4 + (c >> 5)) * 512 + ((kk & 7) * 32 + (c & 31)) * 2; }
__device__ __forceinline__ int v_rd_base(int lane) { return ((lane & 3) << 3) | (((lane >> 2) & 3) << 6) | (((lane >> 4) & 1) << 5) | (((lane >> 5) & 1) << 8); }
constexpr int v_rd_off(int d0, int ks, int half) { return d0 * 512 + ks * 4096 + half * 2048; }
template <int OFF> __device__ __forceinline__ s16x4 tr_read(int vb) {
    s16x4 r; asm volatile("ds_read_b64_tr_b16 %0, %1 offset:%2" : "=&v"(r) : "v"(vb), "i"(OFF) : "memory"); return r;
}
#define PKLH(L, H) (bf16x8){L[0], L[1], L[2], L[3], H[0], H[1], H[2], H[3]}
template <int D0> __device__ __forceinline__ void pv_one(f32x16& od, int vb, bf16x8 pa0, bf16x8 pa1, bf16x8 pa2, bf16x8 pa3) {
    const s16x4 l0 = tr_read<v_rd_off(D0, 0, 0)>(vb), h0 = tr_read<v_rd_off(D0, 0, 1)>(vb), l1 = tr_read<v_rd_off(D0, 1, 0)>(vb), h1 = tr_read<v_rd_off(D0, 1, 1)>(vb);
    const s16x4 l2 = tr_read<v_rd_off(D0, 2, 0)>(vb), h2 = tr_read<v_rd_off(D0, 2, 1)>(vb), l3 = tr_read<v_rd_off(D0, 3, 0)>(vb), h3 = tr_read<v_rd_off(D0, 3, 1)>(vb);
    asm volatile("s_waitcnt lgkmcnt(0)" ::: "memory"); SBAR();
    od = __builtin_amdgcn_mfma_f32_32x32x16_bf16(pa0, PKLH(l0, h0), od, 0, 0, 0);
    od = __builtin_amdgcn_mfma_f32_32x32x16_bf16(pa1, PKLH(l1, h1), od, 0, 0, 0);
    od = __builtin_amdgcn_mfma_f32_32x32x16_bf16(pa2, PKLH(l2, h2), od, 0, 0, 0);
    od = __builtin_amdgcn_mfma_f32_32x32x16_bf16(pa3, PKLH(l3, h3), od, 0, 0, 0);
}
__device__ __forceinline__ void pv_d0(f32x16* o, int vb, bf16x8 pa0, bf16x8 pa1, bf16x8 pa2, bf16x8 pa3) {
    pv_one<0>(o[0], vb, pa0, pa1, pa2, pa3); pv_one<1>(o[1], vb, pa0, pa1, pa2, pa3); pv_one<2>(o[2], vb, pa0, pa1, pa2, pa3); pv_one<3>(o[3], vb, pa0, pa1, pa2, pa3);
}
__device__ __forceinline__ void pack_p(const f32x16& p0, const f32x16& p1, bf16x8& pa0, bf16x8& pa1, bf16x8& pa2, bf16x8& pa3) {
#define PK4(P, BASE, OUT) do { unsigned a0 = cvtpk(P[BASE + 0], P[BASE + 1]), a1 = cvtpk(P[BASE + 2], P[BASE + 3]);   \
    unsigned b0 = cvtpk(P[BASE + 4], P[BASE + 5]), b1 = cvtpk(P[BASE + 6], P[BASE + 7]);                              \
    auto r0 = __builtin_amdgcn_permlane32_swap(a0, b0, false, false); auto r1 = __builtin_amdgcn_permlane32_swap(a1, b1, false, false); \
    u32x4 w = {r0[0], r1[0], r0[1], r1[1]}; OUT = *reinterpret_cast<bf16x8*>(&w); } while (0)
    PK4(p0, 0, pa0); PK4(p0, 8, pa1); PK4(p1, 0, pa2); PK4(p1, 8, pa3);
#undef PK4
}
__device__ __forceinline__ void qkt(f32x16& p0, f32x16& p1, const char* Ks, const bf16x8* qr, int r32, int hi) {
    p0 = f32x16{}; p1 = f32x16{};
#pragma unroll
    for (int d0 = 0; d0 < 8; ++d0) { int cb = (d0 * 16 + hi * 8) * 2;
        bf16x8 b0 = *reinterpret_cast<const bf16x8*>(Ks + KSWZ(r32, cb));
        bf16x8 b1 = *reinterpret_cast<const bf16x8*>(Ks + KSWZ(32 + r32, cb));
        p0 = __builtin_amdgcn_mfma_f32_32x32x16_bf16(b0, qr[d0], p0, 0, 0, 0);
        p1 = __builtin_amdgcn_mfma_f32_32x32x16_bf16(b1, qr[d0], p1, 0, 0, 0); }
}

namespace attn {
constexpr int D = 128, NW = 8, QBLK = 32, KVBLK = 64;
constexpr float SCALE = 0.088388347648318440f, THR = 8.f;
constexpr int LDQ = NIN, LDK = NIN, LDO = DM;
constexpr size_t SHM_V = KVBLK * D * 2, SHM_K = KVBLK * D * 2;
__device__ __forceinline__ void partialSM(f32x16& p0, f32x16& p1, float& m_reg, float& mn, float& alpha) {
    constexpr float C = SCALE * 1.4426950408889634f;
    float pmax = p0[0];
#pragma unroll
    for (int r = 1; r < 16; ++r) pmax = fmaxf(pmax, p0[r]);
#pragma unroll
    for (int r = 0; r < 16; ++r) pmax = fmaxf(pmax, p1[r]);
    { auto rr = __builtin_amdgcn_permlane32_swap(__float_as_uint(pmax), __float_as_uint(pmax), false, false);
      pmax = fmaxf(__uint_as_float(rr[0]), __uint_as_float(rr[1])); }
    if (__builtin_expect(__all(pmax - m_reg <= THR / SCALE), 1)) { mn = m_reg; alpha = 1.f; }
    else { mn = fmaxf(m_reg, pmax); alpha = __builtin_amdgcn_exp2f((m_reg - mn) * C); m_reg = mn; }
    float mnC = -mn * C;
#pragma unroll
    for (int r = 0; r < 16; ++r) p0[r] = fmaf(p0[r], C, mnC);
#pragma unroll
    for (int r = 0; r < 16; ++r) p1[r] = fmaf(p1[r], C, mnC);
#pragma unroll
    for (int r = 0; r < 16; ++r) p0[r] = __builtin_amdgcn_exp2f(p0[r]);
}
__device__ __forceinline__ void finishSM(f32x16& p0, f32x16& p1, float alpha, float& l_reg, bf16x8& pa0, bf16x8& pa1, bf16x8& pa2, bf16x8& pa3) {
#pragma unroll
    for (int r = 0; r < 16; ++r) p1[r] = __builtin_amdgcn_exp2f(p1[r]);
    float ps = 0;
#pragma unroll
    for (int r = 0; r < 16; ++r) ps += p0[r];
#pragma unroll
    for (int r = 0; r < 16; ++r) ps += p1[r];
    { auto rr = __builtin_amdgcn_permlane32_swap(__float_as_uint(ps), __float_as_uint(ps), false, false);
      ps = __uint_as_float(rr[0]) + __uint_as_float(rr[1]); }
    l_reg = l_reg * alpha + ps;
    pack_p(p0, p1, pa0, pa1, pa2, pa3);
}
__device__ __forceinline__ void body(const bf16_t* __restrict__ Qb, const bf16_t* __restrict__ Kc, const bf16_t* __restrict__ Vc, int nctx,
                                     const bf16_t* __restrict__ Kl, const bf16_t* __restrict__ Vl, bf16_t* __restrict__ Ob, int seq, char* lds, int wv) {
    int tid_ = (wv << 6) | lane_id(); asm volatile("" : "+v"(tid_)); const int tid = tid_, wid = tid >> 6, lane = tid & 63, r32 = lane & 31, hi = lane >> 5;
    char* V_lds = lds; char* K_lds = lds + 2 * SHM_V;
    float* wsp = (float*)(lds + 2 * SHM_V + 2 * SHM_K) + wid * 64; float* li_l = wsp; float* al_l = wsp + 32;
    float m_reg = -1e30f, l_reg = 0; f32x16 o[4] = {}; bf16x8 qr[8];
    const bf16_t* Qw = Qb + (long)(wid * QBLK + r32) * LDQ + hi * 8;
#pragma unroll
    for (int d0 = 0; d0 < 8; ++d0) qr[d0] = *reinterpret_cast<const bf16x8*>(Qw + d0 * 16);
    const int sr = tid >> 4, sc = (tid & 15) * 8, vst0 = v_st(sr, sc), vst1 = v_st(32 + sr, sc);
    const int vb0 = (int)(uintptr_t)V_lds + v_rd_base(lane);
    struct { bf16x8 vs0, vs1, ks0, ks1; } sr_[2];
#define SLOAD(i, k0) do { const int _k = (k0); const bf16_t* _kp = (_k < nctx) ? Kc + (long)_k * LDK : Kl + (long)(_k - nctx) * LDK; const bf16_t* _vp = (_k < nctx) ? Vc + (long)_k * LDK : Vl + (long)(_k - nctx) * LDK; \
    sr_[i].vs0 = *reinterpret_cast<const bf16x8*>(&_vp[(long)sr * LDK + sc]); sr_[i].vs1 = *reinterpret_cast<const bf16x8*>(&_vp[(long)(32 + sr) * LDK + sc]); \
    sr_[i].ks0 = *reinterpret_cast<const bf16x8*>(&_kp[(long)sr * LDK + sc]); sr_[i].ks1 = *reinterpret_cast<const bf16x8*>(&_kp[(long)(32 + sr) * LDK + sc]); } while (0)
#define SWRITE(b, i) do { *(bf16x8*)(V_lds + (b) * SHM_V + vst0) = sr_[i].vs0;          \
    *(bf16x8*)(V_lds + (b) * SHM_V + vst1) = sr_[i].vs1; int kc = sc * 2;               \
    *(bf16x8*)(K_lds + (b) * SHM_K + KSWZ(sr, kc)) = sr_[i].ks0;                       \
    *(bf16x8*)(K_lds + (b) * SHM_K + KSWZ(32 + sr, kc)) = sr_[i].ks1; } while (0)
#define SWAIT() asm volatile("s_waitcnt vmcnt(4)" ::: "memory")
#define RESC(a) do { if (__any((a) < 1.f)) { if (hi == 0) al_l[r32] = (a); asm volatile("s_waitcnt lgkmcnt(0)" ::: "memory"); \
    _Pragma("unroll") for (int d = 0; d < 4; ++d) _Pragma("unroll") for (int r = 0; r < 16; ++r) o[d][r] *= al_l[crow(r, hi)]; } } while (0)
    f32x16 pA0, pA1, pB0, pB1; float mnA, mnB, alA, alB; bf16x8 pa0, pa1, pa2, pa3; const int NT = seq / KVBLK;
    constexpr int SE = 0, SO = 1;
    SLOAD(SE, 0); asm volatile("s_waitcnt vmcnt(0)" ::: "memory"); SWRITE(0, SE); __syncthreads();
    qkt(pA0, pA1, K_lds, qr, r32, hi); partialSM(pA0, pA1, m_reg, mnA, alA);
    SLOAD(SO, KVBLK); if (2 < NT) SLOAD(SE, 2 * KVBLK);
    SWAIT(); SWRITE(1, SO); __syncthreads();
    for (int j = 1; j + 1 < NT; j += 2) {
        SBAR(); qkt(pB0, pB1, K_lds + SHM_K, qr, r32, hi);
        finishSM(pA0, pA1, alA, l_reg, pa0, pa1, pa2, pa3); SBAR();
        SLOAD(SO, (j + 2) * KVBLK); SBAR();
        pv_d0(o, vb0, pa0, pa1, pa2, pa3); partialSM(pB0, pB1, m_reg, mnB, alB);
        __syncthreads(); SWAIT(); SWRITE(0, SE);
        RESC(alB); __syncthreads();
        SBAR(); qkt(pA0, pA1, K_lds, qr, r32, hi);
        finishSM(pB0, pB1, alB, l_reg, pa0, pa1, pa2, pa3); SBAR();
        if (j + 3 < NT) SLOAD(SE, (j + 3) * KVBLK); SBAR();
        pv_d0(o, vb0 + (int)SHM_V, pa0, pa1, pa2, pa3); partialSM(pA0, pA1, m_reg, mnA, alA);
        __syncthreads(); SWAIT(); SWRITE(1, SO);
        RESC(alA); __syncthreads();
    }
    SBAR(); qkt(pB0, pB1, K_lds + SHM_K, qr, r32, hi);
    finishSM(pA0, pA1, alA, l_reg, pa0, pa1, pa2, pa3); SBAR();
    pv_d0(o, vb0, pa0, pa1, pa2, pa3); partialSM(pB0, pB1, m_reg, mnB, alB);
    __syncthreads(); RESC(alB);
    finishSM(pB0, pB1, alB, l_reg, pa0, pa1, pa2, pa3); SBAR();
    pv_d0(o, vb0 + (int)SHM_V, pa0, pa1, pa2, pa3);
    if (hi == 0) li_l[r32] = l_reg; asm volatile("s_waitcnt lgkmcnt(0)" ::: "memory");
    float rli[16];
#pragma unroll
    for (int r = 0; r < 16; ++r) rli[r] = __builtin_amdgcn_rcpf(li_l[crow(r, hi)]);
    bf16_t* Ow = Ob + (long)(wid * QBLK) * LDO;
#pragma unroll
    for (int r = 0; r < 16; ++r) { int orow = crow(r, hi);
#pragma unroll
        for (int d0 = 0; d0 < 4; ++d0) Ow[(long)orow * LDO + d0 * 32 + r32] = (bf16_t)f2bf(o[d0][r] * rli[r]); }
#undef SLOAD
#undef SWRITE
#undef SWAIT
#undef RESC
}
}

struct Args {
    const float* x; const float* c; const float* ctx; const float* c_ctx; const float* mod_w; const float* mod_b;
    const float* norm1_g; const float* norm2_g; const float* ab_w_in; const float* ab_w_out; const float* ret_decay;
    const float* q_g; const float* k_g; const float* cm_w_in; const float* cm_v_g; const float* cm_w_s; const float* cm_b_s;
    const float* cm_w_out; const float* ff_w1; const float* ff_w2;
    float* out; unsigned char* ws; int ph_lo, ph_hi;
};

__device__ __forceinline__ void transpose_item(const float* W, int K, int N, bf16_t* WT, float* scr, int item, int lane, bool perm = false) {
    const int nblk = N / 32, kb = item / nblk, nb = item % nblk, k0 = 64 * kb, n0 = 32 * nb;
#pragma unroll 8
    for (int i = 0; i < 32; ++i) { const int kk = 2 * i + (lane >> 5); scr[kk * 33 + (lane & 31)] = W[(size_t)(k0 + kk) * N + (perm ? pg8::inproj_orig_col(n0 + (lane & 31)) : n0 + (lane & 31))]; }
    LDS_WAIT(); asm volatile("" ::: "memory");
    const int c = lane & 7;
#pragma unroll
    for (int j = 0; j < 4; ++j) { const int n = (lane >> 3) + 8 * j; const float* s = scr + (8 * c) * 33 + n;
        u32x4 o; o.x = cvtpk(s[0 * 33], s[1 * 33]); o.y = cvtpk(s[2 * 33], s[3 * 33]); o.z = cvtpk(s[4 * 33], s[5 * 33]); o.w = cvtpk(s[6 * 33], s[7 * 33]);
        *(u32x4*)(WT + (size_t)(n0 + n) * K + k0 + 8 * c) = o; }
    LDS_WAIT(); asm volatile("" ::: "memory");
}

__device__ __forceinline__ void gemv17_item(char* lds, const float* W, int ldw, float* out, int ldo, const float* bias, int j0, int wv, int permbase = -1) {
    int tid_ = (wv << 6) | lane_id(); asm volatile("" : "+v"(tid_)); const int tid = tid_, lane = tid & 63, wave = tid >> 6;
    const float* T = (const float*)lds; float* red = (float*)(lds + 81920);
    float acc[17];
#pragma unroll
    for (int jj = 0; jj < 17; ++jj) acc[jj] = 0.f;
    const float* wp = W + (size_t)(wave * 128) * ldw + (permbase >= 0 ? pg8::inproj_orig_col(permbase + lane) - permbase : lane);
#pragma unroll 1
    for (int kb = 0; kb < 128; kb += 8) {
        float wvv[8];
#pragma unroll
        for (int i = 0; i < 8; ++i) wvv[i] = wp[(size_t)(kb + i) * ldw];
#pragma unroll
        for (int i = 0; i < 8; ++i) { const float wv = wvv[i]; const float* tp = T + (wave * 128 + kb + i) * 20;
            const f32x4 t0 = *(const f32x4*)(tp), t1 = *(const f32x4*)(tp + 4), t2 = *(const f32x4*)(tp + 8), t3 = *(const f32x4*)(tp + 12); const float t16 = tp[16];
            acc[0] += t0[0] * wv; acc[1] += t0[1] * wv; acc[2] += t0[2] * wv; acc[3] += t0[3] * wv;
            acc[4] += t1[0] * wv; acc[5] += t1[1] * wv; acc[6] += t1[2] * wv; acc[7] += t1[3] * wv;
            acc[8] += t2[0] * wv; acc[9] += t2[1] * wv; acc[10] += t2[2] * wv; acc[11] += t2[3] * wv;
            acc[12] += t3[0] * wv; acc[13] += t3[1] * wv; acc[14] += t3[2] * wv; acc[15] += t3[3] * wv; acc[16] += t16 * wv; }
    }
#pragma unroll
    for (int jj = 0; jj < 17; ++jj) red[(jj * 8 + wave) * 64 + lane] = acc[jj];
    __syncthreads();
    for (int e = tid; e < 17 * 64; e += 512) { const int jj = e >> 6, ln = e & 63, j = j0 + jj; float s = 0.f;
#pragma unroll
        for (int w = 0; w < 8; ++w) s += red[(jj * 8 + w) * 64 + ln];
        if (j < 33) out[(size_t)j * ldo + ln] = s + (bias ? bias[ln] : 0.f); }
    __syncthreads();
}

__device__ __forceinline__ void transposes(const Args& a, char* lds, int G, int wv, int lo, int hi) {
    int tid_ = (wv << 6) | lane_id(); asm volatile("" : "+v"(tid_)); const int tid = tid_, lane = tid & 63, wave = tid >> 6;
    const int gw = blockIdx.x * 8 + wave, NGW = G * 8;
    unsigned char* ws = a.ws;
    float* scr = (float*)(lds + wave * 16384);
    constexpr int I_ABIN = 16 * 96, I_SQ = 16 * 32, I_CMIN = 16 * 64, I_FF = 16 * 128;
    constexpr int NITEMS = 2 * I_ABIN + 2 * I_SQ + 2 * I_CMIN + 2 * I_SQ + 4 * I_FF + 4 * I_FF;
    for (int it = lo + gw; it < (hi < NITEMS ? hi : NITEMS); it += NGW) {
        int r = it;
        if (r < 2 * I_ABIN) { const int i = r / I_ABIN; transpose_item(a.ab_w_in + (size_t)i * 1024 * 3072, 1024, 3072, (bf16_t*)(ws + WS_WABIN) + (size_t)i * 3072 * 1024, scr, r % I_ABIN, lane, true); continue; } r -= 2 * I_ABIN;
        if (r < 2 * I_SQ) { const int i = r / I_SQ; transpose_item(a.ab_w_out + (size_t)i * 1024 * 1024, 1024, 1024, (bf16_t*)(ws + WS_WABOUT) + (size_t)i * 1024 * 1024, scr, r % I_SQ, lane); continue; } r -= 2 * I_SQ;
        if (r < 2 * I_CMIN) { const int i = r / I_CMIN; transpose_item(a.cm_w_in + (size_t)i * 1024 * 2048, 1024, 2048, (bf16_t*)(ws + WS_WCMIN) + (size_t)i * 2048 * 1024, scr, r % I_CMIN, lane); continue; } r -= 2 * I_CMIN;
        if (r < 2 * I_SQ) { const int i = r / I_SQ; transpose_item(a.cm_w_out + (size_t)i * 1024 * 1024, 1024, 1024, (bf16_t*)(ws + WS_WCMOUT) + (size_t)i * 1024 * 1024, scr, r % I_SQ, lane); continue; } r -= 2 * I_SQ;
        if (r < 4 * I_FF) { const int i = r / I_FF; transpose_item(a.ff_w1 + (size_t)i * 1024 * 4096, 1024, 4096, (bf16_t*)(ws + WS_WFF1) + (size_t)i * 4096 * 1024, scr, r % I_FF, lane); continue; } r -= 4 * I_FF;
        { const int i = r / I_FF; transpose_item(a.ff_w2 + (size_t)i * 4096 * 1024, 4096, 1024, (bf16_t*)(ws + WS_WFF2) + (size_t)i * 1024 * 4096, scr, r % I_FF, lane); }
    }
}

__device__ __forceinline__ void prologue(const Args& a, char* lds, int G, int wv) {
    int tid_ = (wv << 6) | lane_id(); asm volatile("" : "+v"(tid_)); const int tid = tid_, lane = tid & 63, wave = tid >> 6;
    const int gw = blockIdx.x * 8 + wave, NGW = G * 8;
    unsigned char* ws = a.ws;
    transposes(a, lds, G, wv, 0, 16 * 96);
    { bf16_t* wsb = (bf16_t*)(ws + WS_WSB);
      for (int i = blockIdx.x * 512 + tid; i < 2 * 8 * 128 * 128 / 2; i += G * 512) { const float2 v = ((const float2*)a.cm_w_s)[i]; ((unsigned*)wsb)[i] = cvtpk(v.x, v.y); } }
    { float* rc = (float*)(ws + WS_ROPE); float* rs = rc + 2048 * 64;
      for (int i = blockIdx.x * 512 + tid; i < 2048 * 64; i += G * 512) { const int t = i >> 6, j = i & 63; const int f = j & 31;
          const float inv = exp2f(-(float)f * (13.287712379549449f / 32.0f));
          const float pos = (j < 32) ? (float)(t >> 6) : (float)(t & 63);
          const float ang = pos * inv; rc[i] = cosf(ang); rs[i] = sinf(ang); } }
    __syncthreads();
    float* MOD = (float*)(ws + WS_MOD);
#pragma unroll 1
    for (int pass = 0; pass < 2; ++pass) {
        const int j0 = pass * 17;
        float* T = (float*)lds;
        for (int e = tid; e < 17 * 1024; e += 512) { const int jj = e >> 10, k = e & 1023, j = j0 + jj; float v = 0.f;
            if (j < 33) { const float cv = (j < 32) ? a.c[j * 1024 + k] : a.c_ctx[k]; v = cv / (1.0f + __expf(-cv)); }
            T[k * 20 + jj] = v; }
        __syncthreads();
        for (int item = blockIdx.x; item < 4 * 96; item += G) {
            const int l = item / 96, n0 = (item % 96) * 64;
            gemv17_item(lds, a.mod_w + (size_t)l * 1024 * 6144 + n0, 6144, MOD + (size_t)l * 33 * 6144 + n0, 6144, a.mod_b + l * 6144 + n0, j0, wv);
        }
        __syncthreads();
    }
}

__device__ __forceinline__ void shw_phase(const Args& a, char* lds, int G, int wv) {
    int tid_ = (wv << 6) | lane_id(); asm volatile("" : "+v"(tid_)); const int tid = tid_;
    const float* MOD = (const float*)(a.ws + WS_MOD); float* SHW = (float*)(a.ws + WS_SHW);
    int base = 0;
#pragma unroll 1
    for (int e = 1; e < 8; ++e) {
        const int l = e >> 1, which = e & 1, li = l >> 1;
        const int N = which ? 4096 : ((l & 1) ? 2048 : 3072);
        const float* W = which ? a.ff_w1 + (size_t)l * 1024 * 4096 : ((l & 1) ? a.cm_w_in + (size_t)li * 1024 * 2048 : a.ab_w_in + (size_t)li * 1024 * 3072);
        const float* sh = MOD + (size_t)l * 33 * 6144 + which * 3072;
        const int nit = N / 64;
#pragma unroll 1
        for (int pass = 0; pass < 2; ++pass) {
            const int first = ((blockIdx.x - base) % G + G) % G;
            if (first < nit) {
                const int j0 = pass * 17; float* T = (float*)lds;
                __syncthreads();
                for (int x = tid; x < 17 * 1024; x += 512) { const int jj = x >> 10, k = x & 1023, j = j0 + jj; T[k * 20 + jj] = (j < 33) ? sh[(size_t)j * 6144 + k] : 0.f; }
                __syncthreads();
                for (int it = first; it < nit; it += G)
                    gemv17_item(lds, W + it * 64, N, SHW + (size_t)e * 33 * 4096 + it * 64, 4096, nullptr, j0, wv, (which == 0 && (l & 1) == 0) ? it * 64 : -1);
            }
            base += nit;
        }
    }
    __syncthreads();
}

__device__ __forceinline__ void norm_phase(const float* xlat, const float* xctx, const float* g, const float* modl, int which, bf16_t* XN, int Mrows, int ngw, int wv) {
    int tid_ = (wv << 6) | lane_id(); asm volatile("" : "+v"(tid_)); const int lane = tid_ & 63, gw = blockIdx.x * 8 + (tid_ >> 6);
    for (int r = gw; r < Mrows; r += ngw) {
        const float* src = r < RLAT ? xlat + (size_t)r * 1024 : xctx + (size_t)(r - RLAT) * 1024;
        const int bidx = r < RLAT ? (r >> 11) : 32;
        const float* mp = modl + (size_t)bidx * 6144 + which * 3072;
        f32x4 v[4]; float s = 0.f;
#pragma unroll
        for (int j = 0; j < 4; ++j) { v[j] = ((const f32x4*)src)[lane + 64 * j]; s += (v[j][0] * v[j][0] + v[j][1] * v[j][1]) + (v[j][2] * v[j][2] + v[j][3] * v[j][3]); }
        const float rinv = rsqrtf(wave_sum(s) * (1.0f / 1024.0f) + EPS);
        u32x2* o8 = (u32x2*)(XN + (size_t)r * 1024);
#pragma unroll
        for (int j = 0; j < 4; ++j) { const int c4 = lane + 64 * j; const f32x4 gv = ((const f32x4*)g)[c4], sh = ((const f32x4*)mp)[c4], sc = ((const f32x4*)(mp + 1024))[c4];
            const f32x4 y = (v[j] * rinv * gv) * (sc + 1.0f) + sh; u32x2 w; w.x = cvtpk(y[0], y[1]); w.y = cvtpk(y[2], y[3]); o8[c4] = w; }
    }
}

struct RnRow { bf16x8 a1, a2, b1, b2; f32x4 c0, c1, s0, s1; };
__device__ __forceinline__ RnRow rn_load(const bf16_t* P, const float* ropec, const float* ropes, int r, int col0, int col1, int sub) {
    RnRow d; const bf16_t* prow = P + (size_t)r * NIN;
    d.a1 = *reinterpret_cast<const bf16x8*>(prow + col0); d.a2 = *reinterpret_cast<const bf16x8*>(prow + col0 + 64);
    d.b1 = *reinterpret_cast<const bf16x8*>(prow + col1); d.b2 = *reinterpret_cast<const bf16x8*>(prow + col1 + 64);
    const int t = r & 2047;
    d.c0 = *(const f32x4*)(ropec + t * 64 + sub * 8); d.c1 = *(const f32x4*)(ropec + t * 64 + sub * 8 + 4);
    d.s0 = *(const f32x4*)(ropes + t * 64 + sub * 8); d.s1 = *(const f32x4*)(ropes + t * 64 + sub * 8 + 4);
    return d;
}
__device__ __forceinline__ void rn_process(bf16_t* P, int r, const RnRow& d, int col0, int col1, int hs, float mul0, const float (&ga1)[8], const float (&ga2)[8]) {
    bf16_t* prow = P + (size_t)r * NIN; const bool lat = r < RLAT;
    float cs[8], sn[8];
#pragma unroll
    for (int e = 0; e < 4; ++e) { cs[e] = lat ? d.c0[e] : 1.f; cs[4 + e] = lat ? d.c1[e] : 1.f; sn[e] = lat ? d.s0[e] : 0.f; sn[4 + e] = lat ? d.s1[e] : 0.f; }
    if (lat || hs >= 4) { float o1[8], o2[8];
#pragma unroll
        for (int e = 0; e < 8; ++e) { const float x1 = bf2f((bf16_t)d.a1[e]) * mul0, x2 = bf2f((bf16_t)d.a2[e]) * mul0; o1[e] = x1 * cs[e] - x2 * sn[e]; o2[e] = x1 * sn[e] + x2 * cs[e]; }
        u32x4 w1, w2; w1.x = cvtpk(o1[0], o1[1]); w1.y = cvtpk(o1[2], o1[3]); w1.z = cvtpk(o1[4], o1[5]); w1.w = cvtpk(o1[6], o1[7]);
        w2.x = cvtpk(o2[0], o2[1]); w2.y = cvtpk(o2[2], o2[3]); w2.z = cvtpk(o2[4], o2[5]); w2.w = cvtpk(o2[6], o2[7]);
        *(u32x4*)(prow + col0) = w1; *(u32x4*)(prow + col0 + 64) = w2; }
    { float y1[8], y2[8]; float ss = 0.f;
#pragma unroll
      for (int e = 0; e < 8; ++e) { y1[e] = bf2f((bf16_t)d.b1[e]); y2[e] = bf2f((bf16_t)d.b2[e]); ss += y1[e] * y1[e] + y2[e] * y2[e]; }
      ss += shx(ss, 1); ss += shx(ss, 2); ss += shx(ss, 4);
      const float rinv = rsqrtf(ss * (1.0f / 128.0f) + EPS);
      if (hs < 6) { float o1[8], o2[8];
#pragma unroll
        for (int e = 0; e < 8; ++e) { const float x1 = y1[e] * rinv * ga1[e], x2 = y2[e] * rinv * ga2[e]; o1[e] = x1 * cs[e] - x2 * sn[e]; o2[e] = x1 * sn[e] + x2 * cs[e]; }
        u32x4 w1, w2; w1.x = cvtpk(o1[0], o1[1]); w1.y = cvtpk(o1[2], o1[3]); w1.z = cvtpk(o1[4], o1[5]); w1.w = cvtpk(o1[6], o1[7]);
        w2.x = cvtpk(o2[0], o2[1]); w2.y = cvtpk(o2[2], o2[3]); w2.z = cvtpk(o2[4], o2[5]); w2.w = cvtpk(o2[6], o2[7]);
        *(u32x4*)(prow + col1) = w1; *(u32x4*)(prow + col1 + 64) = w2; } }
}
__device__ __forceinline__ void ropenorm_phase(bf16_t* P, const float* ropec, const float* ropes, const float* qg, const float* kg, int ngw, bool dry, int wv) {
    int tid_ = (wv << 6) | lane_id(); asm volatile("" : "+v"(tid_)); const int lane = tid_ & 63, gw = blockIdx.x * 8 + (tid_ >> 6);
    (void)dry;
    const int sub = lane & 7, hs = lane >> 3;
    float ga1[8], ga2[8];
    { const float* gsel = hs < 4 ? qg : kg;
#pragma unroll
      for (int e = 0; e < 8; ++e) { ga1[e] = gsel[sub * 8 + e]; ga2[e] = gsel[64 + sub * 8 + e]; } }
    const int col0 = (hs < 4 ? hs * 128 : 512 + (hs - 4) * 128) + sub * 8;
    const int col1 = (hs < 4 ? 2048 + hs * 128 : 2560 + ((hs - 4) & 1) * 128) + sub * 8;
    const float mul0 = hs < 4 ? 1.0f : 0.088388347648318440f;
    for (int r = gw; r < RTOT; r += 2 * ngw) {
        const int r2 = r + ngw; const bool has2 = r2 < RTOT;
        const RnRow d0 = rn_load(P, ropec, ropes, r, col0, col1, sub);
        const RnRow d1 = rn_load(P, ropec, ropes, has2 ? r2 : r, col0, col1, sub);
        rn_process(P, r, d0, col0, col1, hs, mul0, ga1, ga2);
        if (has2) rn_process(P, r2, d1, col0, col1, hs, mul0, ga1, ga2);
    }
}

__device__ __forceinline__ int chunk_rowbase(int b, int cid) { return cid < 2 ? RLAT + b * 256 + cid * 128 : b * 2048 + (cid - 2) * 128; }

__device__ __forceinline__ void ret_state_unit(const bf16_t* P, bf16_t* ST, int b, int h, int dir, float lg2, char* lds, int wv) {
    int tid_ = (wv << 6) | lane_id(); asm volatile("" : "+v"(tid_)); const int tid = tid_, wid = tid >> 6, lane = tid & 63, r32 = lane & 31, hi = lane >> 5;
    const int db = wid & 3, eh = wid >> 2;
    const int sr = tid >> 4, sc = (tid & 15) * 8;
    char* Kt = lds; char* Vt = lds + 32768;
    const int vbA = (int)(uintptr_t)Kt + v_rd_base(lane) + db * 512;
    const int vbB = (int)(uintptr_t)Vt + v_rd_base(lane) + eh * 1024;
    const float cd = exp2f(128.0f * lg2);
    f32x16 st[2] = {};
    bf16_t* STu = ST + (size_t)((b * 4 + h) * 2 + dir) * 18 * 16384;
    bf16x8 kvN[4], vvN[4];
#define RS_LOAD(CID) do { const int rb_ = chunk_rowbase(b, (CID)); _Pragma("unroll") for (int q = 0; q < 4; ++q) { const bf16_t* pr = P + (size_t)(rb_ + q * 32 + sr) * NIN + h * 128 + sc; \
        kvN[q] = *reinterpret_cast<const bf16x8*>(pr + 512); vvN[q] = *reinterpret_cast<const bf16x8*>(pr + 1024); } } while (0)
    RS_LOAD(dir == 0 ? 0 : 1);
#pragma unroll 1
    for (int s = 0; s < 18; ++s) {
        const int cid = dir == 0 ? s : (s == 0 ? 1 : (s == 1 ? 0 : 19 - s));
        bf16_t* Sp = STu + (size_t)cid * 16384;
#pragma unroll
        for (int t = 0; t < 2; ++t)
#pragma unroll
            for (int rg = 0; rg < 4; ++rg) { const int e = (2 * eh + t) * 32 + r32, d = db * 32 + 8 * rg + 4 * hi;
                u32x2 w; w.x = cvtpk(st[t][4 * rg + 0], st[t][4 * rg + 1]); w.y = cvtpk(st[t][4 * rg + 2], st[t][4 * rg + 3]); *(u32x2*)(Sp + e * 128 + d) = w; }
        if (s == 17) break;
        __syncthreads();
#pragma unroll
        for (int q = 0; q < 4; ++q) { const int key = q * 32 + sr; const bf16x8 kv = kvN[q], vv = vvN[q];
            const float kd = exp2f(lg2 * (float)(dir ? key : 127 - key));
            u32x4 w;
            w.x = cvtpk(bf2f((bf16_t)vv[0]) * kd, bf2f((bf16_t)vv[1]) * kd); w.y = cvtpk(bf2f((bf16_t)vv[2]) * kd, bf2f((bf16_t)vv[3]) * kd);
            w.z = cvtpk(bf2f((bf16_t)vv[4]) * kd, bf2f((bf16_t)vv[5]) * kd); w.w = cvtpk(bf2f((bf16_t)vv[6]) * kd, bf2f((bf16_t)vv[7]) * kd);
            const int off = (key >> 6) * 16384 + v_st(key & 63, sc);
            *(bf16x8*)(Kt + off) = kv; *(u32x4*)(Vt + off) = w; }
        __syncthreads();
        if (s + 1 < 17) { const int s1 = s + 1; RS_LOAD(dir == 0 ? s1 : (s1 == 1 ? 0 : 19 - s1)); }
        f32x16 acc[2] = {};
#pragma unroll
        for (int tile = 0; tile < 2; ++tile) {
#define RS_STEP(KS) do { const s16x4 al = tr_read<v_rd_off(0, KS, 0)>(vbA + tile * 16384), ah = tr_read<v_rd_off(0, KS, 1)>(vbA + tile * 16384); \
            const s16x4 b0l = tr_read<v_rd_off(0, KS, 0)>(vbB + tile * 16384), b0h = tr_read<v_rd_off(0, KS, 1)>(vbB + tile * 16384); \
            const s16x4 b1l = tr_read<v_rd_off(1, KS, 0)>(vbB + tile * 16384), b1h = tr_read<v_rd_off(1, KS, 1)>(vbB + tile * 16384); \
            asm volatile("s_waitcnt lgkmcnt(0)" ::: "memory"); SBAR(); \
            acc[0] = __builtin_amdgcn_mfma_f32_32x32x16_bf16(PKLH(al, ah), PKLH(b0l, b0h), acc[0], 0, 0, 0); \
            acc[1] = __builtin_amdgcn_mfma_f32_32x32x16_bf16(PKLH(al, ah), PKLH(b1l, b1h), acc[1], 0, 0, 0); } while (0)
            RS_STEP(0); RS_STEP(1); RS_STEP(2); RS_STEP(3);
#undef RS_STEP
        }
#pragma unroll
        for (int t = 0; t < 2; ++t)
#pragma unroll
            for (int r = 0; r < 16; ++r) st[t][r] = st[t][r] * cd + acc[t][r];
    }
    __syncthreads();
#undef RS_LOAD
}

__device__ __forceinline__ void ret_out_unit(const bf16_t* P, const bf16_t* ST, bf16_t* O, int b, int h, int cid, float lgf, float lgb, char* lds, int wv) {
    int tid_ = (wv << 6) | lane_id(); asm volatile("" : "+v"(tid_)); const int tid = tid_, wid = tid >> 6, lane = tid & 63, r32 = lane & 31, hi = lane >> 5;
    const int rb = wid & 3, eh = wid >> 2;
    const int sr = tid >> 4, sc = (tid & 15) * 8;
    char* Kt = lds; char* Vt = lds + 32768; char* Sf = lds + 65536; char* Sb = lds + 98304;
    const int rowbase = chunk_rowbase(b, cid);
    const bf16_t* Sfg = ST + (size_t)(((b * 4 + h) * 2 + 0) * 18 + cid) * 16384;
    const bf16_t* Sbg = ST + (size_t)(((b * 4 + h) * 2 + 1) * 18 + cid) * 16384;
    __syncthreads();
#pragma unroll
    for (int q = 0; q < 4; ++q) { const int key = q * 32 + sr; const bf16_t* pr = P + (size_t)(rowbase + key) * NIN + h * 128 + sc;
        const bf16x8 kv = __builtin_nontemporal_load(reinterpret_cast<const bf16x8*>(pr + 512)); const bf16x8 vv = __builtin_nontemporal_load(reinterpret_cast<const bf16x8*>(pr + 1024));
        const bf16x8 sf = __builtin_nontemporal_load(reinterpret_cast<const bf16x8*>(Sfg + key * 128 + sc)); const bf16x8 sb = __builtin_nontemporal_load(reinterpret_cast<const bf16x8*>(Sbg + key * 128 + sc));
        *(bf16x8*)(Kt + (key >> 6) * 16384 + KSWZ(key & 63, sc * 2)) = kv;
        *(bf16x8*)(Vt + (key >> 6) * 16384 + v_st(key & 63, sc)) = vv;
        *(bf16x8*)(Sf + KSWZ(key, sc * 2)) = sf; *(bf16x8*)(Sb + KSWZ(key, sc * 2)) = sb; }
    bf16x8 qr[8];
    { const bf16_t* Qw = P + (size_t)(rowbase + rb * 32 + r32) * NIN + h * 128 + hi * 8;
#pragma unroll
      for (int d0 = 0; d0 < 8; ++d0) qr[d0] = *reinterpret_cast<const bf16x8*>(Qw + d0 * 16); }
    __syncthreads();
    f32x16 o[2] = {}, xf[2] = {}, xb[2] = {};
    const int irow = rb * 32 + r32;
    const int vb = (int)(uintptr_t)Vt + v_rd_base(lane) + eh * 1024;
#pragma unroll
    for (int jt = 0; jt < 2; ++jt) {
        f32x16 p0, p1; qkt(p0, p1, Kt + jt * 16384, qr, r32, hi);
#pragma unroll
        for (int r = 0; r < 16; ++r) { const int j0 = jt * 64 + crow(r, hi), d0 = irow - j0, d1 = d0 - 32;
            const float w0 = d0 > 0 ? exp2f(lgf * (float)d0) : (d0 < 0 ? exp2f(lgb * (float)(-d0)) : 2.0f);
            const float w1 = d1 > 0 ? exp2f(lgf * (float)d1) : (d1 < 0 ? exp2f(lgb * (float)(-d1)) : 2.0f);
            p0[r] *= w0; p1[r] *= w1; }
        bf16x8 pa0, pa1, pa2, pa3; pack_p(p0, p1, pa0, pa1, pa2, pa3);
        pv_one<0>(o[0], vb + jt * 16384, pa0, pa1, pa2, pa3); pv_one<1>(o[1], vb + jt * 16384, pa0, pa1, pa2, pa3);
    }
#pragma unroll
    for (int t = 0; t < 2; ++t)
#pragma unroll
        for (int d0 = 0; d0 < 8; ++d0) { const int e = (2 * eh + t) * 32 + r32, cb = (d0 * 16 + hi * 8) * 2;
            const bf16x8 bf = *reinterpret_cast<const bf16x8*>(Sf + KSWZ(e, cb)); const bf16x8 bb = *reinterpret_cast<const bf16x8*>(Sb + KSWZ(e, cb));
            xf[t] = __builtin_amdgcn_mfma_f32_32x32x16_bf16(qr[d0], bf, xf[t], 0, 0, 0);
            xb[t] = __builtin_amdgcn_mfma_f32_32x32x16_bf16(qr[d0], bb, xb[t], 0, 0, 0); }
    __syncthreads();
    float* OT = (float*)lds;
#pragma unroll
    for (int r = 0; r < 16; ++r) { const int i = rb * 32 + crow(r, hi); const float wf = exp2f(lgf * (float)(i + 1)), wb = exp2f(lgb * (float)(128 - i));
#pragma unroll
        for (int t = 0; t < 2; ++t) OT[i * 132 + (2 * eh + t) * 32 + r32] = o[t][r] + wf * xf[t][r] + wb * xb[t][r]; }
    __syncthreads();
    { const int row = tid >> 2, qd = tid & 3; const float* op = OT + row * 132 + qd * 32; f32x4 v[8]; float s = 0.f;
#pragma unroll
      for (int j = 0; j < 8; ++j) { v[j] = *(const f32x4*)(op + 4 * j); s += (v[j][0] + v[j][1]) + (v[j][2] + v[j][3]); }
      s += shx(s, 1); s += shx(s, 2); const float mu = s * (1.0f / 128.0f); float q = 0.f;
#pragma unroll
      for (int j = 0; j < 8; ++j) { v[j] = v[j] - mu; q += (v[j][0] * v[j][0] + v[j][1] * v[j][1]) + (v[j][2] * v[j][2] + v[j][3] * v[j][3]); }
      q += shx(q, 1); q += shx(q, 2); const float rstd = rsqrtf(q * (1.0f / 128.0f) + EPS);
      const bf16_t* gp = P + (size_t)(rowbase + row) * NIN + 1536 + h * 128 + qd * 32; bf16_t* od = O + (size_t)(rowbase + row) * DM + h * 128 + qd * 32;
#pragma unroll
      for (int j = 0; j < 4; ++j) { const bf16x8 gv = *reinterpret_cast<const bf16x8*>(gp + 8 * j); float y[8];
#pragma unroll
          for (int e = 0; e < 8; ++e) { const float g = bf2f((bf16_t)gv[e]); const float sg = g / (1.0f + __expf(-g)); y[e] = v[2 * j + (e >> 2)][e & 3] * rstd * sg; }
          u32x4 w; w.x = cvtpk(y[0], y[1]); w.y = cvtpk(y[2], y[3]); w.z = cvtpk(y[4], y[5]); w.w = cvtpk(y[6], y[7]); *(u32x4*)(od + 8 * j) = w; } }
}

__device__ __forceinline__ void gate_unit(const bf16_t* Z, const float* ssq, const float* vg, const bf16_t* wsb, const float* bs, bf16_t* Gout, int chunk, int gbase, char* lds, int wv) {
    int tid_ = (wv << 6) | lane_id(); asm volatile("" : "+v"(tid_)); const int tid = tid_, wid = tid >> 6, lane = tid & 63, r32 = lane & 31, hi = lane >> 5;
    const int pb = wid & 3, dh = wid >> 2;
    const int sr = tid >> 4, sc = (tid & 15) * 8;
    const int rowbase = chunk * 128;
    char* Vt = lds;
    bf16x8 af[2][8];
#pragma unroll
    for (int gg = 0; gg < 2; ++gg) { const bf16_t* wp = wsb + (size_t)((gbase + gg) * 128 + pb * 32 + r32) * 128 + hi * 8;
#pragma unroll
      for (int k8 = 0; k8 < 8; ++k8) af[gg][k8] = *reinterpret_cast<const bf16x8*>(wp + k8 * 16); }
    f32x4 gsc[2][2];
#pragma unroll
    for (int gg = 0; gg < 2; ++gg) { gsc[gg][0] = *(const f32x4*)(vg + (gbase + gg) * 128 + sc); gsc[gg][1] = *(const f32x4*)(vg + (gbase + gg) * 128 + sc + 4); }
    __syncthreads();
#pragma unroll
    for (int q = 0; q < 4; ++q) { const int key = q * 32 + sr; const int row = rowbase + key;
        const bf16x8 vv0 = __builtin_nontemporal_load(reinterpret_cast<const bf16x8*>(Z + (size_t)row * 2048 + 1024 + gbase * 128 + sc));
        const bf16x8 vv1 = __builtin_nontemporal_load(reinterpret_cast<const bf16x8*>(Z + (size_t)row * 2048 + 1024 + (gbase + 1) * 128 + sc));
        const f32x4 s0 = *(const f32x4*)(ssq + (size_t)row * 16), s1 = *(const f32x4*)(ssq + (size_t)row * 16 + 4), s2 = *(const f32x4*)(ssq + (size_t)row * 16 + 8), s3 = *(const f32x4*)(ssq + (size_t)row * 16 + 12);
        const float tot = ((s0[0] + s0[1]) + (s0[2] + s0[3])) + ((s1[0] + s1[1]) + (s1[2] + s1[3])) + ((s2[0] + s2[1]) + (s2[2] + s2[3])) + ((s3[0] + s3[1]) + (s3[2] + s3[3]));
        const float rinv = rsqrtf(tot * (1.0f / 1024.0f) + EPS);
#pragma unroll
        for (int gg = 0; gg < 2; ++gg) { const bf16x8 vv = gg ? vv1 : vv0; const f32x4 g0 = gsc[gg][0], g1 = gsc[gg][1];
            u32x4 w;
            w.x = cvtpk(bf2f((bf16_t)vv[0]) * rinv * g0[0], bf2f((bf16_t)vv[1]) * rinv * g0[1]); w.y = cvtpk(bf2f((bf16_t)vv[2]) * rinv * g0[2], bf2f((bf16_t)vv[3]) * rinv * g0[3]);
            w.z = cvtpk(bf2f((bf16_t)vv[4]) * rinv * g1[0], bf2f((bf16_t)vv[5]) * rinv * g1[1]); w.w = cvtpk(bf2f((bf16_t)vv[6]) * rinv * g1[2], bf2f((bf16_t)vv[7]) * rinv * g1[3]);
            *(u32x4*)(Vt + gg * 32768 + (key >> 6) * 16384 + v_st(key & 63, sc)) = w; } }
    __syncthreads();
    f32x16 acc[2][2] = {};
    const int vb = (int)(uintptr_t)Vt + v_rd_base(lane) + dh * 1024;
#pragma unroll
    for (int gg = 0; gg < 2; ++gg)
#pragma unroll
    for (int tile = 0; tile < 2; ++tile) {
#define GT_STEP(KS) do { const int vbt = vb + gg * 32768 + tile * 16384; const s16x4 b0l = tr_read<v_rd_off(0, KS, 0)>(vbt), b0h = tr_read<v_rd_off(0, KS, 1)>(vbt); \
        const s16x4 b1l = tr_read<v_rd_off(1, KS, 0)>(vbt), b1h = tr_read<v_rd_off(1, KS, 1)>(vbt); \
        asm volatile("s_waitcnt lgkmcnt(0)" ::: "memory"); SBAR(); \
        acc[gg][0] = __builtin_amdgcn_mfma_f32_32x32x16_bf16(af[gg][tile * 4 + KS], PKLH(b0l, b0h), acc[gg][0], 0, 0, 0); \
        acc[gg][1] = __builtin_amdgcn_mfma_f32_32x32x16_bf16(af[gg][tile * 4 + KS], PKLH(b1l, b1h), acc[gg][1], 0, 0, 0); } while (0)
        GT_STEP(0); GT_STEP(1); GT_STEP(2); GT_STEP(3);
#undef GT_STEP
    }
#pragma unroll
    for (int gg = 0; gg < 2; ++gg) { const int g = gbase + gg;
#pragma unroll
    for (int r = 0; r < 16; ++r) { const int p = pb * 32 + crow(r, hi); const float bias = bs[g * 128 + p];
        const bf16_t* up = Z + (size_t)(rowbase + p) * 2048 + g * 128; bf16_t* gp = Gout + (size_t)(rowbase + p) * DM + g * 128;
#pragma unroll
        for (int t = 0; t < 2; ++t) { const int d = (2 * dh + t) * 32 + r32; gp[d] = (bf16_t)f2bf(bf2f(up[d]) * (acc[gg][t][r] + bias)); } } }
}


#ifdef NO_ATT
#define PH_ATT(...) do {} while (0)
#else
#define PH_ATT(...) __VA_ARGS__
#endif
#ifdef NO_RS
#define PH_RS(...) do {} while (0)
#else
#define PH_RS(...) __VA_ARGS__
#endif
#ifdef NO_RO
#define PH_RO(...) do {} while (0)
#else
#define PH_RO(...) __VA_ARGS__
#endif
#ifdef NO_GT
#define PH_GT(...) do {} while (0)
#else
#define PH_GT(...) __VA_ARGS__
#endif
#ifdef NO_PRO
#define PH_PRO(...) do {} while (0)
#else
#define PH_PRO(...) __VA_ARGS__
#endif
#ifdef NO_GEMM
#define PH_GEMM(...) do {} while (0)
#else
#define PH_GEMM(...) __VA_ARGS__
#endif

#ifndef DUPMASK
#define DUPMASK 0
#endif
#ifndef DUPSYNC
#define DUPSYNC 0
#endif
#ifndef DUPGATE
#define DUPGATE 0
#endif
#define GSYNC() do { XcdBarrier b_; b_.bar = barp; asm volatile("" : "+s"(b_.bar)); unsigned x_ = xb_xcc_id(); asm volatile("" : "+s"(x_)); b_.x = x_; b_.st = bst; xcd_barrier(b_, (wv == 0) && (lane_id() == 0)); if (DUPSYNC) xcd_barrier(b_, (wv == 0) && (lane_id() == 0)); } while (0)
#define REPS(id) ((((DUPMASK) >> (id)) & 1) ? 2 : 1)
#define XB_TMO      128
#define XB_XCNT(j)  (256  + 64 * (j))
#define XB_XSUB(j)  (1280 + 64 * (j))
#define XB_XGEN(j)  (2304 + 64 * (j))
#define XB_TOP      3328
#define XB_TOPGEN   3392
#define XCD_BAR_WORDS 3456
#define XB_SPIN_CAP (1u << 18)

__device__ __forceinline__ unsigned xb_ld(unsigned* p)              { return __hip_atomic_load(p, __ATOMIC_RELAXED, __HIP_MEMORY_SCOPE_AGENT); }
__device__ __forceinline__ unsigned xb_add(unsigned* p, unsigned v) { return __hip_atomic_fetch_add(p, v, __ATOMIC_RELAXED, __HIP_MEMORY_SCOPE_AGENT); }
__device__ __forceinline__ unsigned xb_xcc_id() { return (unsigned)__builtin_amdgcn_s_getreg((3 << 11) | 20) & 0xFu; }
#define XB_SPIN(cond, bar) do { unsigned _sp = 0; while (cond) { __builtin_amdgcn_s_sleep(1); \
    if ((++_sp & 255u) == 0u) { if (xb_ld(&(bar)[XB_TMO])) break; if (_sp > XB_SPIN_CAP) { atomicAdd(&(bar)[XB_TMO], 1u); break; } } } } while (0)

struct XcdBarrier {
    unsigned* bar; unsigned x;
    volatile __attribute__((address_space(3))) unsigned* st;
};

__device__ __forceinline__ XcdBarrier xcd_barrier_post(unsigned* bar, volatile __attribute__((address_space(3))) unsigned* st) {
    XcdBarrier b; b.bar = bar; b.x = xb_xcc_id(); b.st = st;
    if (threadIdx.x == 0) (void)xb_add(&bar[XB_XCNT(b.x)], 1u);
    return b;
}
__device__ __forceinline__ void xcd_barrier_complete(unsigned* bar, unsigned x, unsigned& nloc, unsigned& nx) {
    const unsigned G = gridDim.x * gridDim.y * gridDim.z;
    unsigned sum, cnt, mine, sp = 0u;
    for (;;) {
        sum = 0u; cnt = 0u; mine = 0u;
#pragma unroll
        for (unsigned j = 0; j < 16; ++j) { const unsigned c = xb_ld(&bar[XB_XCNT(j)]); sum += c; cnt += (c > 0u) ? 1u : 0u; mine = (j == x) ? c : mine; }
        if (sum == G) break;
        __builtin_amdgcn_s_sleep(1);
        if ((++sp & 255u) == 0u) { if (xb_ld(&bar[XB_TMO])) break; if (sp > XB_SPIN_CAP) { atomicAdd(&bar[XB_TMO], 1u); break; } }
    }
    nloc = mine > 0u ? mine : 1u; nx = cnt > 0u ? cnt : 1u;
}

__device__ __forceinline__ void xcd_barrier(const XcdBarrier& b, bool leader_thread) {
    asm volatile("s_waitcnt vmcnt(0)" ::: "memory");
    __syncthreads();
    if (leader_thread) {
        unsigned* bar = b.bar;
        __builtin_amdgcn_s_waitcnt(0);
        unsigned nloc = b.st[0], nx = b.st[1];
        if (nloc == 0u) { xcd_barrier_complete(bar, b.x, nloc, nx); b.st[0] = nloc; b.st[1] = nx; }
        const unsigned old = xb_add(&bar[XB_XSUB(b.x)], 1u);
        const unsigned gen = old / nloc;
        if (old + 1u == (gen + 1u) * nloc) {
            __builtin_amdgcn_fence(__ATOMIC_RELEASE, "agent");
            asm volatile("s_waitcnt vmcnt(0)" ::: "memory");
            const unsigned og = xb_add(&bar[XB_TOP], 1u);
            const unsigned tg = og / nx;
            if (og + 1u == (tg + 1u) * nx) xb_add(&bar[XB_TOPGEN], 1u);
            else XB_SPIN(xb_ld(&bar[XB_TOPGEN]) == tg, bar);
            __builtin_amdgcn_fence(__ATOMIC_ACQUIRE, "agent");
            xb_add(&bar[XB_XGEN(b.x)], 1u);
            asm volatile("s_waitcnt vmcnt(0)" ::: "memory");
        } else {
            XB_SPIN(xb_ld(&bar[XB_XGEN(b.x)]) == gen, bar);
            __builtin_amdgcn_fence(__ATOMIC_ACQUIRE, "agent");
            asm volatile("s_waitcnt vmcnt(0)" ::: "memory");
        }
    }
    __syncthreads();
}

__global__ void __launch_bounds__(512, 2) mk_fwd(Args a) {
    extern __shared__ __attribute__((aligned(16))) unsigned char lds_raw[];
    cg::grid_group grid = cg::this_grid();
    char* lds = (char*)lds_raw;
    const int G = gridDim.x, bx = blockIdx.x;
    const int NGW = G * 8;
    const int wv = __builtin_amdgcn_readfirstlane(threadIdx.x >> 6);
    unsigned char* ws = a.ws;
    float* MOD = (float*)(ws + WS_MOD);
    const float* ropec = (const float*)(ws + WS_ROPE); const float* ropes = ropec + 2048 * 64;
    bf16_t* XN = (bf16_t*)(ws + WS_XN); bf16_t* XS = (bf16_t*)(ws + WS_XS); bf16_t* BIG = (bf16_t*)(ws + WS_BIG); bf16_t* ST = (bf16_t*)(ws + WS_ST);
    float* XCTX = (float*)(ws + WS_XCTX); float* SSQ = (float*)(ws + WS_SSQ); float* SSQA = (float*)(ws + WS_SSQA); float* SSQB = (float*)(ws + WS_SSQB);
    const float* SHW = (const float*)(ws + WS_SHW);
    PG8_LAS unsigned char* glds = (PG8_LAS unsigned char*)lds_raw;
    volatile __attribute__((address_space(3))) unsigned* bst = (volatile __attribute__((address_space(3))) unsigned*)(glds + 147392);
    if (threadIdx.x < 2) bst[threadIdx.x] = 0u;
    __syncthreads();
    unsigned* barp = (unsigned*)ws + 4096;
    { XcdBarrier b0_ = xcd_barrier_post(barp, bst); (void)b0_; }

for (int rep = 0; rep < REPS(0); ++rep) {
    prologue(a, lds, G, wv);
    grid.sync();
}
for (int rep = 0; rep < REPS(1); ++rep) {
    norm_phase(a.x, a.ctx, a.norm1_g, MOD, 0, XN, RTOT, NGW, wv);
    transposes(a, lds, G, wv, 16 * 96, 1 << 30);
    __syncthreads();
    shw_phase(a, lds, G, wv);
    GSYNC();
}

#pragma unroll 1
    for (int l = 0; l < DEPTH; ++l) {
        const bool even = (l & 1) == 0; const int li = l >> 1;
        const int Mrows = (l == DEPTH - 1) ? RLAT : RTOT;
        const float* modl = MOD + (size_t)l * 33 * 6144;
        const float* xin_lat = (l == 0) ? a.x : a.out; const float* xin_ctx = (l == 0) ? a.ctx : XCTX;
        const bool ctx_post = l < 2;
        const int Mpost = ctx_post ? RTOT : RLAT;
        const bool nrm_in = l > 0;
        if (even) {
for (int rep = 0; rep < REPS(2); ++rep) {
            { const bool cl = !ctx_post && Mrows == RTOT;
              pg8::Gemm g{XN, (const bf16_t*)(ws + WS_WABIN) + (size_t)li * 3072 * 1024, Mrows, NIN, DM}; pg8::NormOrder S; S.init(cl ? RLAT : Mrows, NIN, G, bx); S.ctx_live = cl ? 32 : 0; S.ssq = SSQB; S.lds = glds; S.wv = wv; S.dummy = MOD; S.on = nrm_in; S.v0 = nrm_in ? SHW + (size_t)(2 * l) * 33 * 4096 : nullptr; S.ld0 = 4096; S.v1 = nullptr; S.v2 = nullptr; S.ld2 = 0;
              pg8::EpiInProj E{BIG, nrm_in, glds, ropec, ropes, a.q_g + li * 128, a.k_g + li * 128};
              pg8::gemm_phase<pg8::EpiInProj, pg8::NormOrder, true, true>(glds, g, S, E); }
            GSYNC();
}
            for (int rep = 0; rep < REPS(4); ++rep) {
            for (int u = bx; u < 1024 + 256 + (ctx_post ? 128 : 0); u += G) {
                if (u < 1024) {
                    const int rnd = u >> 8, v = u & 255, x = v & 7, y = v >> 3; const int grp = rnd * 16 + x * 2 + (y >> 4);
                    const int b = grp >> 1, kvh = grp & 1, h = kvh * 2 + ((y >> 3) & 1), qb = y & 7;
                    const bf16_t* Pl = BIG + (size_t)(b * 2048) * NIN; const bf16_t* Pc = BIG + (size_t)(RLAT + b * 256) * NIN;
                    attn::body(Pl + (size_t)(qb * 256) * NIN + 2048 + h * 128, Pc + 2560 + kvh * 128, Pc + 2816 + kvh * 128, 256,
                               Pl + 2560 + kvh * 128, Pl + 2816 + kvh * 128, XN + (size_t)(b * 2048 + qb * 256) * DM + 512 + h * 128, 2304, lds, wv);
                    __syncthreads();
                } else if (u < 1280) {
                    const int v = u - 1024, b = v >> 3, h = (v >> 1) & 3, dir = v & 1;
                    const float xd = a.ret_decay[(li * 2 + dir) * 4 + h]; const float lg2 = -log1pf(expf(-xd)) * 1.4426950408889634f;
                    ret_state_unit(BIG, ST, b, h, dir, lg2, lds, wv);
                } else {
                    const int v = u - 1280, b = v >> 2, h = v & 3, kvh = h >> 1;
                    const bf16_t* Pc = BIG + (size_t)(RLAT + b * 256) * NIN;
                    attn::body(Pc + 2048 + h * 128, Pc + 2560 + kvh * 128, Pc + 2816 + kvh * 128, 256, Pc, Pc, XN + (size_t)(RLAT + b * 256) * DM + 512 + h * 128, 256, lds, wv);
                    __syncthreads();
                }
            }
            GSYNC();
            }
            for (int rep = 0; rep < REPS(5); ++rep) {
            for (int u = bx; u < 32 * 4 * (ctx_post ? 18 : 16); u += G) {
                const int ncid = ctx_post ? 18 : 16; const int cid = (u % ncid) + (18 - ncid), bh = u / ncid, b = bh >> 2, h = bh & 3;
                const float xf_ = a.ret_decay[(li * 2 + 0) * 4 + h], xb_ = a.ret_decay[(li * 2 + 1) * 4 + h];
                const float lgf = -log1pf(expf(-xf_)) * 1.4426950408889634f, lgb = -log1pf(expf(-xb_)) * 1.4426950408889634f;
                ret_out_unit(BIG, ST, XN, b, h, cid, lgf, lgb, lds, wv);
            }
            __syncthreads();
            GSYNC();
            }
for (int rep = 0; rep < (DUPGATE ? 2 : 1); ++rep) { const bool dummy_ = DUPGATE && rep == 0;
            { pg8::Gemm g{XN, (const bf16_t*)(ws + WS_WABOUT) + (size_t)li * 1024 * 1024, Mpost, DM, DM}; pg8::NormOrder S; S.init(Mpost, DM, G, bx); S.ssq = nullptr; S.lds = glds; S.wv = wv; S.dummy = MOD; S.on = false; S.v0 = modl + 2048; S.ld0 = 6144; S.v1 = a.norm2_g + l * 1024; S.v2 = modl + 4096; S.ld2 = 6144;
              pg8::EpiGate E{dummy_, xin_lat, xin_ctx, a.out, XCTX, glds, true, XS, SSQA};
              pg8::gemm_phase<pg8::EpiGate, pg8::NormOrder, true, true>(glds, g, S, E); }
            GSYNC();
}
        } else {
for (int rep = 0; rep < REPS(7); ++rep) {
            { pg8::Gemm g{XN, (const bf16_t*)(ws + WS_WCMIN) + (size_t)li * 2048 * 1024, Mrows, 2048, DM}; pg8::NormOrder S; S.init(Mrows, 2048, G, bx); S.ssq = SSQB; S.lds = glds; S.wv = wv; S.dummy = MOD; S.on = true; S.v0 = SHW + (size_t)(2 * l) * 33 * 4096; S.ld0 = 4096; S.v1 = nullptr; S.v2 = nullptr; S.ld2 = 0;
              pg8::EpiBf16<1> E{BIG, 2048, SSQ, true, glds};
              pg8::gemm_phase<pg8::EpiBf16<1>, pg8::NormOrder, true, true>(glds, g, S, E); }
            GSYNC();
}
            for (int rep = 0; rep < REPS(8); ++rep) {
            for (int u = bx; u < (Mrows / 128) * 4; u += G)
                gate_unit(BIG, SSQ, a.cm_v_g + li * 1024, (const bf16_t*)(ws + WS_WSB) + (size_t)li * 8 * 128 * 128, a.cm_b_s + li * 8 * 128, XN, u >> 2, (u & 3) * 2, lds, wv);
            __syncthreads();
            GSYNC();
            }
for (int rep = 0; rep < (DUPGATE ? 2 : 1); ++rep) { const bool dummy_ = DUPGATE && rep == 0;
            { pg8::Gemm g{XN, (const bf16_t*)(ws + WS_WCMOUT) + (size_t)li * 1024 * 1024, Mrows, DM, DM}; pg8::NormOrder S; S.init(Mrows, DM, G, bx); S.ssq = nullptr; S.lds = glds; S.wv = wv; S.dummy = MOD; S.on = false; S.v0 = modl + 2048; S.ld0 = 6144; S.v1 = a.norm2_g + l * 1024; S.v2 = modl + 4096; S.ld2 = 6144;
              pg8::EpiGate E{dummy_, xin_lat, xin_ctx, a.out, XCTX, glds, true, XS, SSQA};
              pg8::gemm_phase<pg8::EpiGate, pg8::NormOrder, true, true>(glds, g, S, E); }
            GSYNC();
}
        }
for (int rep = 0; rep < REPS(11); ++rep) {
        { const int Mf = Mrows < Mpost ? Mrows : Mpost; pg8::Gemm g{XS, (const bf16_t*)(ws + WS_WFF1) + (size_t)l * 4096 * 1024, Mf, FF, DM}; pg8::NormOrder S; S.init(Mf, FF, G, bx); S.ssq = SSQA; S.lds = glds; S.wv = wv; S.dummy = MOD; S.on = true; S.v0 = SHW + (size_t)(2 * l + 1) * 33 * 4096; S.ld0 = 4096; S.v1 = nullptr; S.v2 = nullptr; S.ld2 = 0;
          pg8::EpiBf16<2> E{BIG, FF, nullptr, true, glds};
          pg8::gemm_phase<pg8::EpiBf16<2>, pg8::NormOrder, true, true>(glds, g, S, E); }
        GSYNC();
}
for (int rep = 0; rep < (DUPGATE ? 2 : 1); ++rep) { const bool dummy_ = DUPGATE && rep == 0;
        { const bool nx = l + 1 < DEPTH; const int ln = nx ? l + 1 : l;
          const int Mf = Mrows < Mpost ? Mrows : Mpost; pg8::Gemm g{BIG, (const bf16_t*)(ws + WS_WFF2) + (size_t)l * 1024 * 4096, Mf, DM, FF}; pg8::NormOrder S; S.init(Mf, DM, G, bx); S.ssq = nullptr; S.lds = glds; S.wv = wv; S.dummy = MOD; S.on = false; S.v0 = modl + 5 * 1024; S.ld0 = 6144; S.v1 = a.norm1_g + ln * 1024; S.v2 = MOD + (size_t)ln * 33 * 6144 + 1024; S.ld2 = 6144;
          pg8::EpiGate E{dummy_, a.out, XCTX, a.out, XCTX, glds, nx, XN, SSQB};
          pg8::gemm_phase<pg8::EpiGate, pg8::NormOrder, true, true>(glds, g, S, E); }
        GSYNC();
}
    }
}

extern "C" void kernel_launch(void* const* d_in, const int* in_sizes, int n_in, void* d_out, int out_size, void* d_ws, size_t ws_size, hipStream_t stream) {
    static int grid = 0;
    if (grid == 0) {
        if (n_in != 20 || out_size != RLAT * DM || ws_size < WS_END) { fprintf(stderr, "kernel_launch: unexpected shapes: n_in %d out %d ws %zu (need %zu)\n", n_in, out_size, ws_size, (size_t)WS_END); grid = -1; return; }
        int dev = 0, cus = 0, per_cu = 0;
        (void)hipGetDevice(&dev);
        (void)hipDeviceGetAttribute(&cus, hipDeviceAttributeMultiprocessorCount, dev);
        if (hipFuncSetAttribute((const void*)mk_fwd, hipFuncAttributeMaxDynamicSharedMemorySize, LDS_BYTES) != hipSuccess) { fprintf(stderr, "kernel_launch: hipFuncSetAttribute failed\n"); grid = -1; return; }
        (void)hipOccupancyMaxActiveBlocksPerMultiprocessor(&per_cu, (const void*)mk_fwd, 512, LDS_BYTES);
        if (per_cu < 1) { fprintf(stderr, "kernel_launch: occupancy query says %d blocks per CU\n", per_cu); per_cu = 1; }
        grid = cus * per_cu;
    }
    if (grid < 0) return;
    if (hipMemsetAsync((char*)d_ws + 16384, 0, 14336, stream) != hipSuccess) { fprintf(stderr, "kernel_launch: memset failed\n"); return; }
    Args a{};
    a.x = (const float*)d_in[0]; a.c = (const float*)d_in[1]; a.ctx = (const float*)d_in[2]; a.c_ctx = (const float*)d_in[3]; a.mod_w = (const float*)d_in[4]; a.mod_b = (const float*)d_in[5];
    a.norm1_g = (const float*)d_in[6]; a.norm2_g = (const float*)d_in[7]; a.ab_w_in = (const float*)d_in[8]; a.ab_w_out = (const float*)d_in[9]; a.ret_decay = (const float*)d_in[10];
    a.q_g = (const float*)d_in[11]; a.k_g = (const float*)d_in[12]; a.cm_w_in = (const float*)d_in[13]; a.cm_v_g = (const float*)d_in[14]; a.cm_w_s = (const float*)d_in[15]; a.cm_b_s = (const float*)d_in[16];
    a.cm_w_out = (const float*)d_in[17]; a.ff_w1 = (const float*)d_in[18]; a.ff_w2 = (const float*)d_in[19];
    a.out = (float*)d_out; a.ws = (unsigned char*)d_ws; a.ph_lo = 0; a.ph_hi = 0;
    void* args[] = {&a};
    hipError_t e = hipLaunchCooperativeKernel((const void*)mk_fwd, dim3(grid), dim3(512), args, LDS_BYTES, stream);
    if (e != hipSuccess) fprintf(stderr, "kernel_launch: cooperative launch failed: %s (grid %d)\n", hipGetErrorString(e), grid);
}
```

```cpp
#include <hip/hip_runtime.h>
#include <hip/hip_cooperative_groups.h>
#include <cstdio>
#include <cstdint>
namespace cg = cooperative_groups;

namespace pg8 {
#define PG8_LAS __attribute__((address_space(3)))
typedef unsigned short bf16_t;
typedef short bf16x8 __attribute__((ext_vector_type(8)));
typedef float f32x4 __attribute__((ext_vector_type(4)));
typedef unsigned u32x4 __attribute__((ext_vector_type(4)));
constexpr int BM = 256, BK = 64, HALF = 128, HTB = HALF * BK * 2, STAGE_BYTES = 8 * HTB, NXCD = 8, WGM = 4;

__host__ __device__ __forceinline__ int lds_byte(int r, int c) { const int st = (r >> 4) * 2 + (c >> 5), rr = r & 15, cc = c & 31, ob = rr * 64 + cc * 2; return st * 1024 + (ob ^ (((ob >> 9) & 1) << 5)); }
__host__ __device__ __forceinline__ void stage_rc(int b, int& R, int& C) { const int st = b / 1024, sb = b % 1024, swz = sb ^ (((sb >> 9) & 1) << 5); R = (st >> 1) * 16 + swz / 64; C = (st & 1) * 32 + (swz % 64) / 2; }
__host__ __device__ __forceinline__ int perm32(int rho) { const int n = rho >> 4, i = rho & 15; return 8 * (i >> 2) + 4 * n + (i & 3); }

__device__ __forceinline__ int lane_id() { int l = (int)__builtin_amdgcn_mbcnt_hi(~0u, __builtin_amdgcn_mbcnt_lo(~0u, 0u)); asm volatile("" : "+v"(l)); return l; }
__device__ __forceinline__ float shx(float v, int k) { const int src = (lane_id() ^ k) << 2; return __int_as_float(__builtin_amdgcn_ds_bpermute(src, __float_as_int(v))); }
struct Unit { int pm, pn, par; };
struct Gemm { const bf16_t* A; const bf16_t* Bt; int M, N, K; };

struct StaticOrder {
    int nM, nN, nwg, G, c;
    __host__ __device__ void init(int M, int N, int G_, int c_) { nM = M / BM; nN = N / BM; nwg = nM * nN; G = G_; c = c_; }
    __host__ __device__ bool next(int i, Unit& u) const {
        const long L = (long)i * G + c; if (L >= nwg) return false;
        int wgid = (int)L; { const int q = nwg / NXCD, r = nwg % NXCD, xcd = wgid % NXCD, off = wgid / NXCD; wgid = (xcd < r ? xcd * (q + 1) : r * (q + 1) + (xcd - r) * q) + off; }
        const int nig = WGM * nN, gid = wgid / nig, fm = gid * WGM, gsz = (nM - fm) < WGM ? (nM - fm) : WGM;
        u.pm = fm + ((wgid % nig) % gsz); u.pn = (wgid % nig) / gsz; u.par = i & 1; return true;
    }
    __device__ __forceinline__ void a_ready(const Unit&) const {}
    __device__ __forceinline__ void done(const Unit&) const {}
};

constexpr int RINV_LDS_OFF = 131072 + 2048;
__device__ __forceinline__ unsigned lds_addr(PG8_LAS unsigned char* p) { return (unsigned)(__SIZE_TYPE__)p; }
__device__ __forceinline__ void lds_st_f32(unsigned addr, float v) { asm volatile("ds_write_b32 %0, %1" :: "v"(addr), "v"(v) : "memory"); }
__device__ __forceinline__ void lds_ld8_rows(unsigned addr, float (&r)[2][4]) {
    asm volatile("ds_read_b32 %0, %8\n\tds_read_b32 %1, %8 offset:64\n\tds_read_b32 %2, %8 offset:128\n\tds_read_b32 %3, %8 offset:192\n\t"
                 "ds_read_b32 %4, %8 offset:512\n\tds_read_b32 %5, %8 offset:576\n\tds_read_b32 %6, %8 offset:640\n\tds_read_b32 %7, %8 offset:704\n\ts_waitcnt lgkmcnt(0)"
                 : "=&v"(r[0][0]), "=&v"(r[0][1]), "=&v"(r[0][2]), "=&v"(r[0][3]), "=&v"(r[1][0]), "=&v"(r[1][1]), "=&v"(r[1][2]), "=&v"(r[1][3]) : "v"(addr) : "memory");
}
__device__ __forceinline__ void lds_ld4x4(unsigned addr, f32x4& a, f32x4& b, f32x4& c, f32x4& d, const int) {
    asm volatile("ds_read_b128 %0, %4\n\tds_read_b128 %1, %4 offset:16\n\tds_read_b128 %2, %4 offset:512\n\tds_read_b128 %3, %4 offset:528\n\ts_waitcnt lgkmcnt(0)"
                 : "=&v"(a), "=&v"(b), "=&v"(c), "=&v"(d) : "v"(addr) : "memory");
}
__device__ __forceinline__ void lds_ld4x4_f32(unsigned addr, f32x4& a, f32x4& b, f32x4& c, f32x4& d) {
    asm volatile("ds_read_b128 %0, %4\n\tds_read_b128 %1, %4 offset:64\n\tds_read_b128 %2, %4 offset:512\n\tds_read_b128 %3, %4 offset:576\n\ts_waitcnt lgkmcnt(0)"
                 : "=&v"(a), "=&v"(b), "=&v"(c), "=&v"(d) : "v"(addr) : "memory");
}
constexpr int CV_LDS_OFF = RINV_LDS_OFF + 2048;
struct RinvPf { f32x4 a, b; float c0, c1, c2; };
struct NormOrder : StaticOrder {
    const float* ssq; PG8_LAS unsigned char* lds; bool on; int wv; const float* dummy;
    int ctx_live = 0;
    __host__ __device__ bool next(int i, Unit& u) const {
        if (!ctx_live) return StaticOrder::next(i, u);
        const long L = (long)i * G + c;
        if (L < nwg) return StaticOrder::next(i, u);
        const long Lc = L - nwg; if (Lc >= (long)ctx_live * 6) return false;
        const int j = (int)(Lc % 6); u.pm = nM + (int)(Lc / 6); u.pn = j < 4 ? 2 + j : 6 + j; u.par = i & 1; return true;
    }
    const float* v0; int ld0; const float* v1; const float* v2; int ld2;
    __device__ __forceinline__ RinvPf prefetch(const Unit& u, bool has) const {
        RinvPf r; const int t = (wv << 6) | lane_id();
        const bool colt = t >= 256; const int bidx = u.pm < 256 ? (u.pm >> 3) : 32; const int col = u.pn * BM + (t & 255);
        const float* pa = (has && on) ? ssq + (size_t)(u.pm * BM + (t >> 1)) * 16 + (t & 1) * 8 : dummy;
        const float* p0 = (has && colt && v0) ? v0 + (size_t)bidx * ld0 + col : dummy;
        const float* p1 = (has && colt && v1) ? v1 + col : dummy;
        const float* p2 = (has && colt && v1) ? v2 + (size_t)bidx * ld2 + col : dummy;
        const f32x4* p = (const f32x4*)pa; r.a = p[0]; r.b = p[1];
        r.c0 = *p0; r.c1 = *p1; r.c2 = *p2;
        return r;
    }
    __device__ __forceinline__ void commit(const Unit& u, bool has, const RinvPf& r) const {
        const int t = (wv << 6) | lane_id();
        float s = ((r.a[0] + r.a[1]) + (r.a[2] + r.a[3])) + ((r.b[0] + r.b[1]) + (r.b[2] + r.b[3]));
        s += shx(s, 1);
        const float rinv = 1.0f / sqrtf(fabsf(s) * (1.0f / 1024.0f) + 1e-6f); const float gsv = r.c1 * (1.0f + r.c2);
        if (has) {
            if (on && (t & 1) == 0) lds_st_f32(lds_addr(lds) + RINV_LDS_OFF + (u.par * 256 + (t >> 1)) * 4, rinv);
            if (t >= 256) { const unsigned ca = lds_addr(lds) + CV_LDS_OFF + (u.par * 768 + (t - 256)) * 4; lds_st_f32(ca, r.c0); lds_st_f32(ca + 1024, gsv); }
        }
    }
    __device__ __forceinline__ void a_ready(const Unit& u) const { const RinvPf r = prefetch(u, true); commit(u, true, r); }
};
__device__ __forceinline__ unsigned cvt_pk_bf16(float lo, float hi) { unsigned r; asm volatile("v_cvt_pk_bf16_f32 %0, %1, %2" : "=v"(r) : "v"(lo), "v"(hi)); return r; }
__device__ __forceinline__ float gelu_tanh(float x) {
    const float u = 0.7978845608f * (x + 0.044715f * x * x * x);
    const float e = __builtin_amdgcn_exp2f(-2.885390082f * u);
    return x * __builtin_amdgcn_rcpf(1.0f + e);
}
constexpr int RLAT_ROWS = 65536;
template <int ACT> struct EpiBf16 {
    static constexpr bool PERM = true, AFTER_DRAIN = false;
    bf16_t* O; int ldc; float* ssq; bool nrm; PG8_LAS unsigned char* lds;
    __device__ __forceinline__ void operator()(const f32x4 (&acc)[2][2][4][2], const Unit& u, int wr, int wc, int fr_in, int fq) const {
        int fr = fr_in; asm volatile("" : "+v"(fr));
        const int row0 = u.pm * BM + wr * 64 + fr; const int col0 = u.pn * BM + wc * 32 + 8 * fq;
        const bool dossq = (ACT == 1) && (u.pn >= 4);
        f32x4 sv[2][2]; float rvt[2][4];
        if (nrm) { lds_ld4x4(lds_addr(lds) + CV_LDS_OFF + (u.par * 768 + wc * 32 + 8 * fq) * 4, sv[0][0], sv[0][1], sv[1][0], sv[1][1], 0);
                   lds_ld8_rows(lds_addr(lds) + RINV_LDS_OFF + (u.par * 256 + wr * 64 + fr) * 4, rvt); }
        else {
#pragma unroll
            for (int i = 0; i < 2; ++i) { sv[i][0] = (f32x4){0.f, 0.f, 0.f, 0.f}; sv[i][1] = (f32x4){0.f, 0.f, 0.f, 0.f};
#pragma unroll
                for (int j = 0; j < 4; ++j) rvt[i][j] = 1.0f; } }
#pragma unroll
        for (int ai = 0; ai < 2; ++ai)
#pragma unroll
            for (int m = 0; m < 4; ++m) { bf16_t* rowp = O + (size_t)(row0 + ai * HALF + m * 16) * ldc + col0; float ss = 0.f; const float rv = rvt[ai][m];
#pragma unroll
                for (int bj = 0; bj < 2; ++bj) { f32x4 v0 = acc[ai][bj][m][0] * rv + sv[bj][0], v1 = acc[ai][bj][m][1] * rv + sv[bj][1];
                    if (ACT == 1) {
#pragma unroll
                        for (int e = 0; e < 4; ++e) { v0[e] = gelu_tanh(v0[e]); v1[e] = gelu_tanh(v1[e]); }
                        ss += (v0[0] * v0[0] + v0[1] * v0[1]) + (v0[2] * v0[2] + v0[3] * v0[3]) + (v1[0] * v1[0] + v1[1] * v1[1]) + (v1[2] * v1[2] + v1[3] * v1[3]);
                    }
                    if (ACT == 2) {
#pragma unroll
                        for (int e = 0; e < 4; ++e) { const float a = fmaxf(v0[e], 0.f), b = fmaxf(v1[e], 0.f); v0[e] = a * a; v1[e] = b * b; }
                    }
                    u32x4 w; w.x = cvt_pk_bf16(v0[0], v0[1]); w.y = cvt_pk_bf16(v0[2], v0[3]); w.z = cvt_pk_bf16(v1[0], v1[1]); w.w = cvt_pk_bf16(v1[2], v1[3]);
                    *(u32x4*)(rowp + bj * HALF) = w; }
                if (ACT == 1) { if (dossq) { ss += shx(ss, 16); ss += shx(ss, 32);
                    if (fq == 0) ssq[(size_t)(row0 + ai * HALF + m * 16) * 16 + (u.pn - 4) * 4 + wc] = ss; } }
            }
    }
};

__host__ __device__ __forceinline__ int inproj_orig_col(int n) {
    const bool perm = (n < 1024) || (n >= 2048 && n < 2816);
    if (!perm) return n;
    const int p = n & 127, j = p >> 3, e = p & 7;
    return (n & ~127) + ((e < 4) ? 4 * j + e : 64 + 4 * j + (e - 4));
}
constexpr int QKN_LDS_OFF = CV_LDS_OFF + 6144;
struct EpiInProj {
    static constexpr bool PERM = true, AFTER_DRAIN = false;
    bf16_t* O; bool nrm; PG8_LAS unsigned char* lds; const float* ropec; const float* ropes; const float* qg; const float* kg;
    __device__ __forceinline__ void operator()(const f32x4 (&acc)[2][2][4][2], const Unit& u, int wr, int wc, int fr_in, int fq) const {
        int fr = fr_in; asm volatile("" : "+v"(fr));
        constexpr int ldc = 3072;
        const int row0 = u.pm * BM + wr * 64 + fr; const int col0 = u.pn * BM + wc * 32 + 8 * fq;
        const int kind = u.pn < 2 ? 0 : (u.pn < 4 ? 1 : ((u.pn < 8 || u.pn == 11) ? 2 : (u.pn < 10 ? 3 : 4)));
        const bool lat = u.pm < 256;
        f32x4 sv[2][2]; float rvt[2][4];
        if (nrm) { lds_ld4x4(lds_addr(lds) + CV_LDS_OFF + (u.par * 768 + wc * 32 + 8 * fq) * 4, sv[0][0], sv[0][1], sv[1][0], sv[1][1], 0);
                   lds_ld8_rows(lds_addr(lds) + RINV_LDS_OFF + (u.par * 256 + wr * 64 + fr) * 4, rvt); }
        else {
#pragma unroll
            for (int i = 0; i < 2; ++i) { sv[i][0] = (f32x4){0.f, 0.f, 0.f, 0.f}; sv[i][1] = (f32x4){0.f, 0.f, 0.f, 0.f};
#pragma unroll
                for (int j = 0; j < 4; ++j) rvt[i][j] = 1.0f; } }
        if (kind == 2) {
#pragma unroll
            for (int ai = 0; ai < 2; ++ai)
#pragma unroll
                for (int m = 0; m < 4; ++m) { bf16_t* rowp = O + (size_t)(row0 + ai * HALF + m * 16) * ldc + col0; const float rv = rvt[ai][m];
#pragma unroll
                    for (int bj = 0; bj < 2; ++bj) { const f32x4 v0 = acc[ai][bj][m][0] * rv + sv[bj][0], v1 = acc[ai][bj][m][1] * rv + sv[bj][1];
                        u32x4 w; w.x = cvt_pk_bf16(v0[0], v0[1]); w.y = cvt_pk_bf16(v0[2], v0[3]); w.z = cvt_pk_bf16(v1[0], v1[1]); w.w = cvt_pk_bf16(v1[2], v1[3]);
                        *(u32x4*)(rowp + bj * HALF) = w; } }
            return;
        }
        const int j16 = 4 * wc + fq;
        const bool qkn = kind >= 3;
        f32x4 g0 = (f32x4){1.f, 1.f, 1.f, 1.f}, g1 = g0;
        if (qkn) { const float* g = kind == 3 ? qg : kg; g0 = *(const f32x4*)(g + 4 * j16); g1 = *(const f32x4*)(g + 64 + 4 * j16); }
        const float mul = kind == 1 ? 0.088388347648318440f : 1.0f;
        const unsigned pbase = lds_addr(lds) + QKN_LDS_OFF;
#pragma unroll
        for (int ai = 0; ai < 2; ++ai) {
            float rn[4][2];
#pragma unroll
            for (int m = 0; m < 4; ++m) { rn[m][0] = 1.0f; rn[m][1] = 1.0f; }
            if (qkn) {
#pragma unroll
                for (int m = 0; m < 4; ++m)
#pragma unroll
                    for (int bj = 0; bj < 2; ++bj) { const f32x4 v0 = acc[ai][bj][m][0] * rvt[ai][m] + sv[bj][0], v1 = acc[ai][bj][m][1] * rvt[ai][m] + sv[bj][1];
                        float ss = (v0[0] * v0[0] + v0[1] * v0[1]) + (v0[2] * v0[2] + v0[3] * v0[3]) + (v1[0] * v1[0] + v1[1] * v1[1]) + (v1[2] * v1[2] + v1[3] * v1[3]);
                        ss += shx(ss, 16); ss += shx(ss, 32);
                        if (fq == 0) lds_st_f32(pbase + (((wr * 64 + m * 16 + fr) * 2 + bj) * 4 + wc) * 4, ss); }
                asm volatile("s_waitcnt lgkmcnt(0)" ::: "memory"); __builtin_amdgcn_s_barrier(); asm volatile("" ::: "memory");
#pragma unroll
                for (int m = 0; m < 4; ++m)
#pragma unroll
                    for (int bj = 0; bj < 2; ++bj) { f32x4 pp; asm volatile("ds_read_b128 %0, %1\n\ts_waitcnt lgkmcnt(0)" : "=&v"(pp) : "v"(pbase + (((wr * 64 + m * 16 + fr) * 2 + bj) * 4) * 4) : "memory");
                        rn[m][bj] = 1.0f / sqrtf(((pp[0] + pp[1]) + (pp[2] + pp[3])) * (1.0f / 128.0f) + 1e-6f); }
                asm volatile("s_waitcnt lgkmcnt(0)" ::: "memory"); __builtin_amdgcn_s_barrier(); asm volatile("" ::: "memory");
            }
#pragma unroll
            for (int m = 0; m < 4; ++m) { const int row = row0 + ai * HALF + m * 16; bf16_t* rowp = O + (size_t)row * ldc + col0; const float rv = rvt[ai][m];
                f32x4 cs = (f32x4){1.f, 1.f, 1.f, 1.f}, sn = (f32x4){0.f, 0.f, 0.f, 0.f};
                if (lat) { const int t = row & 2047; cs = *(const f32x4*)(ropec + t * 64 + 4 * j16); sn = *(const f32x4*)(ropes + t * 64 + 4 * j16); }
#pragma unroll
                for (int bj = 0; bj < 2; ++bj) { const float sc_ = rn[m][bj] * mul;
                    const f32x4 v0 = (acc[ai][bj][m][0] * rv + sv[bj][0]) * (g0 * sc_), v1 = (acc[ai][bj][m][1] * rv + sv[bj][1]) * (g1 * sc_);
                    const f32x4 o0 = v0 * cs - v1 * sn, o1 = v0 * sn + v1 * cs;
                    u32x4 w; w.x = cvt_pk_bf16(o0[0], o0[1]); w.y = cvt_pk_bf16(o0[2], o0[3]); w.z = cvt_pk_bf16(o1[0], o1[1]); w.w = cvt_pk_bf16(o1[2], o1[3]);
                    *(u32x4*)(rowp + bj * HALF) = w; } }
        }
    }
};
struct EpiGate {
    static constexpr bool PERM = false, AFTER_DRAIN = false;
    bool dummy; const float* xin_lat; const float* xin_ctx; float* xout_lat; float* xout_ctx; PG8_LAS unsigned char* lds;
    bool nxt; bf16_t* xs; float* ssq;
    __device__ __forceinline__ void operator()(const f32x4 (&acc)[2][2][4][2], const Unit& u, int wr, int wc, int fr_in, int fq) const {
        int fr = fr_in; asm volatile("" : "+v"(fr));
        const bool lat = u.pm < 256; const int bidx = lat ? (u.pm >> 3) : 32;
        const float* xi = lat ? xin_lat + (size_t)u.pm * BM * 1024 : xin_ctx + (size_t)(u.pm - 256) * BM * 1024;
        float* xo = dummy ? xout_ctx + (size_t)(756u << 18) + (size_t)(u.pm & 31) * BM * 1024 : (lat ? xout_lat + (size_t)u.pm * BM * 1024 : xout_ctx + (size_t)(u.pm - 256) * BM * 1024);
        const int col0 = u.pn * BM + wc * 32 + 4 * fq;
        f32x4 gv[2][2], gs[2][2];
        { const unsigned ca = lds_addr(lds) + CV_LDS_OFF + (u.par * 768 + wc * 32 + 4 * fq) * 4;
          lds_ld4x4_f32(ca, gv[0][0], gv[0][1], gv[1][0], gv[1][1]); lds_ld4x4_f32(ca + 1024, gs[0][0], gs[0][1], gs[1][0], gs[1][1]); }
        typedef unsigned u32x2 __attribute__((ext_vector_type(2)));
#pragma unroll
        for (int ai = 0; ai < 2; ++ai)
#pragma unroll
            for (int m = 0; m < 4; ++m) { const int rloc = wr * 64 + fr + ai * HALF + m * 16; const size_t off = (size_t)rloc * 1024 + col0; float ss = 0.f;
                bf16_t* xsp = xs + (size_t)(u.pm * BM + rloc) * 1024 + col0;
#pragma unroll
                for (int bj = 0; bj < 2; ++bj)
#pragma unroll
                    for (int n = 0; n < 2; ++n) { const f32x4 xv = *(const f32x4*)(xi + off + bj * HALF + n * 16);
                        const f32x4 o = xv + gv[bj][n] * acc[ai][bj][m][n];
                        *(f32x4*)(xo + off + bj * HALF + n * 16) = o;
                        if (nxt) { ss += (o[0] * o[0] + o[1] * o[1]) + (o[2] * o[2] + o[3] * o[3]); const f32x4 y = o * gs[bj][n];
                            u32x2 w; w.x = cvt_pk_bf16(y[0], y[1]); w.y = cvt_pk_bf16(y[2], y[3]); *(u32x2*)(xsp + bj * HALF + n * 16) = w; } }
                if (nxt) { ss += shx(ss, 16); ss += shx(ss, 32); if (fq == 0) ssq[(size_t)(u.pm * BM + rloc) * 16 + u.pn * 4 + wc] = ss; }
                if (m == 3) asm volatile("" ::: "memory"); }
    }
};

template <class Epi, class Sched, bool ALIGN_EPI = false, bool SP2 = false>
__device__ __forceinline__ void gemm_phase(PG8_LAS unsigned char* lds, const Gemm g, const Sched& S, const Epi& E) {
    int tid_ = (S.wv << 6) | lane_id(); asm volatile("" : "+v"(tid_));
    const int tid = tid_, wid = __builtin_amdgcn_readfirstlane(tid >> 6), lane = tid & 63, wr = wid >> 2, wc = wid & 3, fr = lane & 15, fq = lane >> 4;
    const int K = g.K, nt = K / BK;
#ifdef GEMM_STAGGER
    { const unsigned grp = (blockIdx.x >> 3) & 3u;
      if (grp) { const unsigned long long t0 = __builtin_amdgcn_s_memrealtime(); while (__builtin_amdgcn_s_memrealtime() - t0 < (unsigned long long)(grp * GEMM_STAGGER)) __builtin_amdgcn_s_sleep(16); } }
#endif
    unsigned voffA[2], voffB[2];
#pragma unroll
    for (int i = 0; i < 2; ++i) { int R, C; stage_rc(tid * 16 + i * 8192, R, C); const int Rb = Epi::PERM ? ((R & ~31) + perm32(R & 31)) : R;
        voffA[i] = (unsigned)(R * K + C) * 2u; voffB[i] = (unsigned)(Rb * K + C) * 2u; }
    const size_t kstep = (size_t)(BK * 2);
    const size_t hstep = (size_t)HALF * K * 2;
    const size_t tstep = 2 * hstep;
    const unsigned ldsw = (unsigned)wid * 1024u;
    const int aoff = lds_byte(wr * 64 + fr, fq * 8), boff = lds_byte(wc * 32 + fr, fq * 8);
#define PG8_SA(b, h) (((b) * 2 + (h)) * HTB)
#define PG8_SB(b, h) ((4 + (b) * 2 + (h)) * HTB)
#define PG8_STAGE(bufoff, gbase, voff) do { _Pragma("unroll") for (int _i = 0; _i < 2; ++_i) \
        __builtin_amdgcn_global_load_lds((const unsigned*)((const char*)(gbase) + (voff)[_i]), (PG8_LAS unsigned*)(lds + (bufoff) + ldsw + _i * 8192), 16, 0, 0); } while (0)
#define PG8_LDA(dst, b, h) do { _Pragma("unroll") for (int m = 0; m < 4; ++m) _Pragma("unroll") for (int k = 0; k < 2; ++k) dst[m][k] = *(const PG8_LAS bf16x8*)(lds + PG8_SA(b, h) + aoff + m * 2048 + k * 1024); } while (0)
#define PG8_LDB(dst, b, h) do { _Pragma("unroll") for (int n = 0; n < 2; ++n) _Pragma("unroll") for (int k = 0; k < 2; ++k) dst[n][k] = *(const PG8_LAS bf16x8*)(lds + PG8_SB(b, h) + boff + n * 2048 + k * 1024); } while (0)
#define PG8_MMA(ai, bj, At, Bt) do { __builtin_amdgcn_s_setprio(1); _Pragma("unroll") for (int m = 0; m < 4; ++m) _Pragma("unroll") for (int n = 0; n < 2; ++n) _Pragma("unroll") for (int k = 0; k < 2; ++k) \
        acc[ai][bj][m][n] = __builtin_amdgcn_mfma_f32_16x16x32_bf16(Bt[n][k], At[m][k], acc[ai][bj][m][n], 0, 0, 0); __builtin_amdgcn_s_setprio(0); } while (0)
#define PG8_WAIT_V(n) asm volatile("s_waitcnt vmcnt(" #n ")" ::: "memory")
#define PG8_WAIT_L(n) asm volatile("s_waitcnt lgkmcnt(" #n ")" ::: "memory")
#define PG8_BAR __builtin_amdgcn_s_barrier()
#define PG8_SCHED __builtin_amdgcn_sched_barrier(0)
    Unit cur, nxt; int ui = 0;
    if (!S.next(0, cur)) return;
    f32x4 acc[2][2][4][2];
#pragma unroll
    for (int a = 0; a < 2; ++a)
#pragma unroll
        for (int b = 0; b < 2; ++b)
#pragma unroll
            for (int m = 0; m < 4; ++m)
#pragma unroll
                for (int n = 0; n < 2; ++n) acc[a][b][m][n] = (f32x4){0.f, 0.f, 0.f, 0.f};
    bf16x8 At[4][2], B0[2][2], B1[2][2];
    const char* cA = (const char*)g.A + (size_t)cur.pm * tstep; const char* cB = (const char*)g.Bt + (size_t)cur.pn * tstep;
    S.a_ready(cur);
    auto pf_ = S.prefetch(cur, false);
    if constexpr (SP2) {
        PG8_STAGE(PG8_SB(0, 0), cB, voffB); PG8_STAGE(PG8_SB(0, 1), cB + hstep, voffB); PG8_STAGE(PG8_SA(0, 0), cA, voffA); PG8_STAGE(PG8_SA(0, 1), cA + hstep, voffA);
        if (wr == 1) PG8_BAR;
        PG8_WAIT_V(2); PG8_BAR;
        PG8_STAGE(PG8_SB(1, 0), cB + kstep, voffB); PG8_STAGE(PG8_SA(1, 0), cA + kstep, voffA); PG8_STAGE(PG8_SB(1, 1), cB + hstep + kstep, voffB);
        PG8_WAIT_V(6); PG8_BAR;
    } else {
        PG8_STAGE(PG8_SB(0, 0), cB, voffB); PG8_STAGE(PG8_SA(0, 0), cA, voffA); PG8_STAGE(PG8_SB(0, 1), cB + hstep, voffB); PG8_STAGE(PG8_SA(0, 1), cA + hstep, voffA);
        if (wr == 1) PG8_BAR;
        PG8_WAIT_V(4); PG8_BAR;
        PG8_STAGE(PG8_SB(1, 0), cB + kstep, voffB); PG8_STAGE(PG8_SA(1, 0), cA + kstep, voffA); PG8_STAGE(PG8_SB(1, 1), cB + hstep + kstep, voffB);
        PG8_WAIT_V(6); PG8_BAR;
    }
    for (;;) {
        const bool has_next = S.next(ui + 1, nxt);
        const char* nA = has_next ? (const char*)g.A + (size_t)nxt.pm * tstep : cA; const char* nB = has_next ? (const char*)g.Bt + (size_t)nxt.pn * tstep : cB;
        for (int t = 0; t < nt; t += 2) {
            const bool last = (t == nt - 2);
            if (last) pf_ = S.prefetch(nxt, has_next);
            const char* a1 = cA + (size_t)(t + 1) * kstep;
            const char* a2 = last ? nA : cA + (size_t)(t + 2) * kstep; const char* b2 = last ? nB : cB + (size_t)(t + 2) * kstep;
            const char* a3 = a2 + kstep; const char* b3 = b2 + kstep;
            if constexpr (SP2) {
            PG8_LDB(B0, 0, 0); PG8_LDB(B1, 0, 1); PG8_SCHED; PG8_LDA(At, 0, 0); PG8_STAGE(PG8_SA(1, 1), a1 + hstep, voffA);
            PG8_WAIT_V(8); PG8_WAIT_L(0); PG8_BAR; PG8_MMA(0, 0, At, B0); PG8_MMA(0, 1, At, B1); PG8_BAR; PG8_SCHED;
            PG8_LDA(At, 0, 1); PG8_STAGE(PG8_SB(0, 0), b2, voffB); PG8_STAGE(PG8_SB(0, 1), b2 + hstep, voffB); PG8_STAGE(PG8_SA(0, 0), a2, voffA);
            PG8_WAIT_V(8); PG8_WAIT_L(0); PG8_BAR; PG8_MMA(1, 0, At, B0); PG8_MMA(1, 1, At, B1); PG8_BAR; PG8_SCHED;
            PG8_LDB(B0, 1, 0); PG8_LDB(B1, 1, 1); PG8_SCHED; PG8_LDA(At, 1, 0); PG8_STAGE(PG8_SA(0, 1), a2 + hstep, voffA);
            PG8_WAIT_V(8); PG8_WAIT_L(0); PG8_BAR; PG8_MMA(0, 0, At, B0); PG8_MMA(0, 1, At, B1); PG8_BAR; PG8_SCHED;
            PG8_LDA(At, 1, 1); PG8_STAGE(PG8_SB(1, 0), b3, voffB); PG8_STAGE(PG8_SB(1, 1), b3 + hstep, voffB); PG8_STAGE(PG8_SA(1, 0), a3, voffA);
            PG8_WAIT_V(8); PG8_WAIT_L(0); PG8_BAR; PG8_MMA(1, 0, At, B0); PG8_MMA(1, 1, At, B1); PG8_BAR; PG8_SCHED;
            } else {
            PG8_LDB(B0, 0, 0); PG8_SCHED; PG8_LDA(At, 0, 0); PG8_STAGE(PG8_SA(1, 1), a1 + hstep, voffA);
            PG8_WAIT_L(8); PG8_BAR; PG8_WAIT_L(0); PG8_MMA(0, 0, At, B0); PG8_BAR; PG8_SCHED;
            PG8_LDB(B1, 0, 1); PG8_STAGE(PG8_SB(0, 0), b2, voffB);
            PG8_BAR; PG8_WAIT_L(0); PG8_MMA(0, 1, At, B1); PG8_BAR;
            PG8_LDA(At, 0, 1); PG8_STAGE(PG8_SA(0, 0), a2, voffA);
            PG8_BAR; PG8_WAIT_L(0); PG8_MMA(1, 0, At, B0); PG8_BAR; PG8_SCHED;
            PG8_STAGE(PG8_SB(0, 1), b2 + hstep, voffB);
            PG8_WAIT_V(6); PG8_BAR; PG8_MMA(1, 1, At, B1); PG8_BAR;
            PG8_LDB(B0, 1, 0); PG8_SCHED; PG8_LDA(At, 1, 0); PG8_STAGE(PG8_SA(0, 1), a2 + hstep, voffA);
            PG8_WAIT_L(8); PG8_BAR; PG8_WAIT_L(0); PG8_MMA(0, 0, At, B0); PG8_BAR; PG8_SCHED;
            PG8_LDB(B1, 1, 1); PG8_STAGE(PG8_SB(1, 0), b3, voffB);
            PG8_BAR; PG8_WAIT_L(0); PG8_MMA(0, 1, At, B1); PG8_BAR;
            PG8_LDA(At, 1, 1); PG8_STAGE(PG8_SA(1, 0), a3, voffA);
            PG8_BAR; PG8_WAIT_L(0); PG8_MMA(1, 0, At, B0); PG8_BAR; PG8_SCHED;
            PG8_STAGE(PG8_SB(1, 1), b3 + hstep, voffB);
            PG8_WAIT_V(6); PG8_BAR; PG8_MMA(1, 1, At, B1); PG8_BAR;
            }
        }
        if constexpr (ALIGN_EPI) { if (wr == 0) PG8_BAR; }
        if constexpr (!Epi::AFTER_DRAIN) { S.commit(nxt, has_next, pf_); E(acc, cur, wr, wc, fr, fq); S.done(cur); }
        if (!has_next) break;
#pragma unroll
        for (int a = 0; a < 2; ++a)
#pragma unroll
            for (int b = 0; b < 2; ++b)
#pragma unroll
                for (int m = 0; m < 4; ++m)
#pragma unroll
                    for (int n = 0; n < 2; ++n) acc[a][b][m][n] = (f32x4){0.f, 0.f, 0.f, 0.f};
        cur = nxt; cA = nA; cB = nB; ++ui;
        if constexpr (ALIGN_EPI) { if (wr == 1) PG8_BAR; }
    }
    PG8_WAIT_V(0);
    if constexpr (!ALIGN_EPI) { if (wr == 0) PG8_BAR; }
    PG8_BAR;
    if constexpr (Epi::AFTER_DRAIN) { E.fused(acc, cur, wr, wc, fr, fq, lds, wid, lane); S.done(cur); }
#ifdef GEMM_IDLE_TAIL
    { const unsigned long long t0 = __builtin_amdgcn_s_memrealtime(); while (__builtin_amdgcn_s_memrealtime() - t0 < (unsigned long long)(GEMM_IDLE_TAIL)) __builtin_amdgcn_s_sleep(32); }
#endif
#undef PG8_SA
#undef PG8_SB
#undef PG8_STAGE
#undef PG8_LDA
#undef PG8_LDB
#undef PG8_MMA
#undef PG8_WAIT_V
#undef PG8_WAIT_L
#undef PG8_BAR
#undef PG8_SCHED
}}

typedef unsigned short bf16_t;
typedef float f32x4 __attribute__((ext_vector_type(4)));
typedef unsigned u32x4 __attribute__((ext_vector_type(4)));
typedef unsigned u32x2 __attribute__((ext_vector_type(2)));
using bf16x8 = __attribute__((ext_vector_type(8))) short;
using s16x4  = __attribute__((ext_vector_type(4))) short;
using f32x16 = __attribute__((ext_vector_type(16))) float;

constexpr int DM = 1024, NB = 32, SEQ = 2048, CTXL = 256, DEPTH = 4, NIN = 3072, FF = 4096;
constexpr int RLAT = NB * SEQ, RCTX = NB * CTXL, RTOT = RLAT + RCTX;
constexpr float EPS = 1e-6f;
constexpr size_t MiB = 1u << 20;
constexpr size_t WS_MOD = 1 * MiB;
constexpr size_t WS_ROPE = 5 * MiB;
constexpr size_t WS_WSB = 6 * MiB;
constexpr size_t WS_SSQ = 7 * MiB;
constexpr size_t WS_WABIN = 12 * MiB;
constexpr size_t WS_WABOUT = 24 * MiB;
constexpr size_t WS_WCMIN = 28 * MiB;
constexpr size_t WS_WCMOUT = 36 * MiB;
constexpr size_t WS_WFF1 = 40 * MiB;
constexpr size_t WS_WFF2 = 72 * MiB;
constexpr size_t WS_XCTX = 104 * MiB;
constexpr size_t WS_XN = 136 * MiB;
constexpr size_t WS_BIG = 280 * MiB;
constexpr size_t WS_ST = WS_BIG + 432 * MiB;
constexpr size_t WS_XS = 856 * MiB;
constexpr size_t WS_SSQA = 1000 * MiB;
constexpr size_t WS_SSQB = 1005 * MiB;
constexpr size_t WS_SHW = 1010 * MiB;
constexpr size_t WS_END = 1015 * MiB;
constexpr int LDS_BYTES = 147456;

__device__ __forceinline__ float bf2f(bf16_t v) { return __uint_as_float((unsigned)v << 16); }
__device__ __forceinline__ unsigned f2bf(float f) { unsigned u = __float_as_uint(f); return (u + 0x7fffu + ((u >> 16) & 1u)) >> 16; }
__device__ __forceinline__ unsigned cvtpk(float lo, float hi) { unsigned r; asm volatile("v_cvt_pk_bf16_f32 %0, %1, %2" : "=v"(r) : "v"(lo), "v"(hi)); return r; }
__device__ __forceinline__ int lane_id() { int l = (int)__builtin_amdgcn_mbcnt_hi(~0u, __builtin_amdgcn_mbcnt_lo(~0u, 0u)); asm volatile("" : "+v"(l)); return l; }
__device__ __forceinline__ float shx(float v, int k) { const int src = (lane_id() ^ k) << 2; return __int_as_float(__builtin_amdgcn_ds_bpermute(src, __float_as_int(v))); }
__device__ __forceinline__ float wave_sum(float v) {
#pragma unroll
    for (int o = 1; o < 64; o <<= 1) v += shx(v, o);
    return v;
}
#define LDS_WAIT() asm volatile("s_waitcnt lgkmcnt(0)" ::: "memory")
#define SBAR() __builtin_amdgcn_sched_barrier(0)
#define KSWZ(row, colB) ((row) * 256 + ((colB) ^ (((row) & 7) << 4)))
__device__ __forceinline__ int crow(int r, int hi) { return (r & 3) + 8 * (r >> 2) + 4 * hi; }

__device__ __forceinline__ int v_st(int k, int c) { const int kk = (k & ~0xC) | ((k & 4) << 1) | ((k & 8) >> 1); return ((kk >> 3) * 4 + (c >> 5)) * 512 + ((kk & 7) * 32 + (c & 31)) * 2; }
__device__ __forceinline__ int v_rd_base(int lane) { return ((lane & 3) << 3) | (((lane >> 2) & 3) << 6) | (((lane >> 4) & 1) << 5) | (((lane >> 5) & 1) << 8); }
constexpr int v_rd_off(int d0, int ks, int half) { return d0 * 512 + ks * 4096 + half * 2048; }
template <int OFF> __device__ __forceinline__ s16x4 tr_read(int vb) {
    s16x4 r; asm volatile("ds_read_b64_tr_b16 %0, %1 offset:%2" : "=&v"(r) : "v"(vb), "i"(OFF) : "memory"); return r;
}
#define PKLH(L, H) (bf16x8){L[0], L[1], L[2], L[3], H[0], H[1], H[2], H[3]}
template <int D0> __device__ __forceinline__ void pv_one(f32x16& od, int vb, bf16x8 pa0, bf16x8 pa1, bf16x8 pa2, bf16x8 pa3) {
    const s16x4 l0 = tr_read<v_rd_off(D0, 0, 0)>(vb), h0 = tr_read<v_rd_off(D0, 0, 1)>(vb), l1 = tr_read<v_rd_off(D0, 1, 0)>(vb), h1 = tr_read<v_rd_off(D0, 1, 1)>(vb);
    const s16x4 l2 = tr_read<v_rd_off(D0, 2, 0)>(vb), h2 = tr_read<v_rd_off(D0, 2, 1)>(vb), l3 = tr_read<v_rd_off(D0, 3, 0)>(vb), h3 = tr_read<v_rd_off(D0, 3, 1)>(vb);
    asm volatile("s_waitcnt lgkmcnt(0)" ::: "memory"); SBAR();
    od = __builtin_amdgcn_mfma_f32_32x32x16_bf16(pa0, PKLH(l0, h0), od, 0, 0, 0);
    od = __builtin_amdgcn_mfma_f32_32x32x16_bf16(pa1, PKLH(l1, h1), od, 0, 0, 0);
    od = __builtin_amdgcn_mfma_f32_32x32x16_bf16(pa2, PKLH(l2, h2), od, 0, 0, 0);
    od = __builtin_amdgcn_mfma_f32_32x32x16_bf16(pa3, PKLH(l3, h3), od, 0, 0, 0);
}
__device__ __forceinline__ void pv_d0(f32x16* o, int vb, bf16x8 pa0, bf16x8 pa1, bf16x8 pa2, bf16x8 pa3) {
    pv_one<0>(o[0], vb, pa0, pa1, pa2, pa3); pv_one<1>(o[1], vb, pa0, pa1, pa2, pa3); pv_one<2>(o[2], vb, pa0, pa1, pa2, pa3); pv_one<3>(o[3], vb, pa0, pa1, pa2, pa3);
}
__device__ __forceinline__ void pack_p(const f32x16& p0, const f32x16& p1, bf16x8& pa0, bf16x8& pa1, bf16x8& pa2, bf16x8& pa3) {
#define PK4(P, BASE, OUT) do { unsigned a0 = cvtpk(P[BASE + 0], P[BASE + 1]), a1 = cvtpk(P[BASE + 2], P[BASE + 3]);   \
    unsigned b0 = cvtpk(P[BASE + 4], P[BASE + 5]), b1 = cvtpk(P[BASE + 6], P[BASE + 7]);                              \
    auto r0 = __builtin_amdgcn_permlane32_swap(a0, b0, false, false); auto r1 = __builtin_amdgcn_permlane32_swap(a1, b1, false, false); \
    u32x4 w = {r0[0], r1[0], r0[1], r1[1]}; OUT = *reinterpret_cast<bf16x8*>(&w); } while (0)
    PK4(p0, 0, pa0); PK4(p0, 8, pa1); PK4(p1, 0, pa2); PK4(p1, 8, pa3);
#undef PK4
}
__device__ __forceinline__ void qkt(f32x16& p0, f32x16& p1, const char* Ks, const bf16x8* qr, int r32, int hi) {
    p0 = f32x16{}; p1 = f32x16{};
#pragma unroll
    for (int d0 = 0; d0 < 8; ++d0) { int cb = (d0 * 16 + hi * 8) * 2;
        bf16x8 b0 = *reinterpret_cast<const bf16x8*>(Ks + KSWZ(r32, cb));
        bf16x8 b1 = *reinterpret_cast<const bf16x8*>(Ks + KSWZ(32 + r32, cb));
        p0 = __builtin_amdgcn_mfma_f32_32x32x16_bf16(b0, qr[d0], p0, 0, 0, 0);
        p1 = __builtin_amdgcn_mfma_f32_32x32x16_bf16(b1, qr[d0], p1, 0, 0, 0); }
}

namespace attn {
constexpr int D = 128, NW = 8, QBLK = 32, KVBLK = 64;
constexpr float SCALE = 0.088388347648318440f, THR = 8.f;
constexpr int LDQ = NIN, LDK = NIN, LDO = DM;
constexpr size_t SHM_V = KVBLK * D * 2, SHM_K = KVBLK * D * 2;
__device__ __forceinline__ void partialSM(f32x16& p0, f32x16& p1, float& m_reg, float& mn, float& alpha) {
    constexpr float C = SCALE * 1.4426950408889634f;
    float pmax = p0[0];
#pragma unroll
    for (int r = 1; r < 16; ++r) pmax = fmaxf(pmax, p0[r]);
#pragma unroll
    for (int r = 0; r < 16; ++r) pmax = fmaxf(pmax, p1[r]);
    { auto rr = __builtin_amdgcn_permlane32_swap(__float_as_uint(pmax), __float_as_uint(pmax), false, false);
      pmax = fmaxf(__uint_as_float(rr[0]), __uint_as_float(rr[1])); }
    if (__builtin_expect(__all(pmax - m_reg <= THR / SCALE), 1)) { mn = m_reg; alpha = 1.f; }
    else { mn = fmaxf(m_reg, pmax); alpha = __builtin_amdgcn_exp2f((m_reg - mn) * C); m_reg = mn; }
    float mnC = -mn * C;
#pragma unroll
    for (int r = 0; r < 16; ++r) p0[r] = fmaf(p0[r], C, mnC);
#pragma unroll
    for (int r = 0; r < 16; ++r) p1[r] = fmaf(p1[r], C, mnC);
#pragma unroll
    for (int r = 0; r < 16; ++r) p0[r] = __builtin_amdgcn_exp2f(p0[r]);
}
__device__ __forceinline__ void finishSM(f32x16& p0, f32x16& p1, float alpha, float& l_reg, bf16x8& pa0, bf16x8& pa1, bf16x8& pa2, bf16x8& pa3) {
#pragma unroll
    for (int r = 0; r < 16; ++r) p1[r] = __builtin_amdgcn_exp2f(p1[r]);
    float ps = 0;
#pragma unroll
    for (int r = 0; r < 16; ++r) ps += p0[r];
#pragma unroll
    for (int r = 0; r < 16; ++r) ps += p1[r];
    { auto rr = __builtin_amdgcn_permlane32_swap(__float_as_uint(ps), __float_as_uint(ps), false, false);
      ps = __uint_as_float(rr[0]) + __uint_as_float(rr[1]); }
    l_reg = l_reg * alpha + ps;
    pack_p(p0, p1, pa0, pa1, pa2, pa3);
}
__device__ __forceinline__ void body(const bf16_t* __restrict__ Qb, const bf16_t* __restrict__ Kc, const bf16_t* __restrict__ Vc, int nctx,
                                     const bf16_t* __restrict__ Kl, const bf16_t* __restrict__ Vl, bf16_t* __restrict__ Ob, int seq, char* lds, int wv) {
    int tid_ = (wv << 6) | lane_id(); asm volatile("" : "+v"(tid_)); const int tid = tid_, wid = tid >> 6, lane = tid & 63, r32 = lane & 31, hi = lane >> 5;
    char* V_lds = lds; char* K_lds = lds + 2 * SHM_V;
    float* wsp = (float*)(lds + 2 * SHM_V + 2 * SHM_K) + wid * 64; float* li_l = wsp; float* al_l = wsp + 32;
    float m_reg = -1e30f, l_reg = 0; f32x16 o[4] = {}; bf16x8 qr[8];
    const bf16_t* Qw = Qb + (long)(wid * QBLK + r32) * LDQ + hi * 8;
#pragma unroll
    for (int d0 = 0; d0 < 8; ++d0) qr[d0] = *reinterpret_cast<const bf16x8*>(Qw + d0 * 16);
    const int sr = tid >> 4, sc = (tid & 15) * 8, vst0 = v_st(sr, sc), vst1 = v_st(32 + sr, sc);
    const int vb0 = (int)(uintptr_t)V_lds + v_rd_base(lane);
    struct { bf16x8 vs0, vs1, ks0, ks1; } sr_[2];
#define SLOAD(i, k0) do { const int _k = (k0); const bf16_t* _kp = (_k < nctx) ? Kc + (long)_k * LDK : Kl + (long)(_k - nctx) * LDK; const bf16_t* _vp = (_k < nctx) ? Vc + (long)_k * LDK : Vl + (long)(_k - nctx) * LDK; \
    sr_[i].vs0 = *reinterpret_cast<const bf16x8*>(&_vp[(long)sr * LDK + sc]); sr_[i].vs1 = *reinterpret_cast<const bf16x8*>(&_vp[(long)(32 + sr) * LDK + sc]); \
    sr_[i].ks0 = *reinterpret_cast<const bf16x8*>(&_kp[(long)sr * LDK + sc]); sr_[i].ks1 = *reinterpret_cast<const bf16x8*>(&_kp[(long)(32 + sr) * LDK + sc]); } while (0)
#define SWRITE(b, i) do { *(bf16x8*)(V_lds + (b) * SHM_V + vst0) = sr_[i].vs0;          \
    *(bf16x8*)(V_lds + (b) * SHM_V + vst1) = sr_[i].vs1; int kc = sc * 2;               \
    *(bf16x8*)(K_lds + (b) * SHM_K + KSWZ(sr, kc)) = sr_[i].ks0;                       \
    *(bf16x8*)(K_lds + (b) * SHM_K + KSWZ(32 + sr, kc)) = sr_[i].ks1; } while (0)
#define SWAIT() asm volatile("s_waitcnt vmcnt(4)" ::: "memory")
#define RESC(a) do { if (__any((a) < 1.f)) { if (hi == 0) al_l[r32] = (a); asm volatile("s_waitcnt lgkmcnt(0)" ::: "memory"); \
    _Pragma("unroll") for (int d = 0; d < 4; ++d) _Pragma("unroll") for (int r = 0; r < 16; ++r) o[d][r] *= al_l[crow(r, hi)]; } } while (0)
    f32x16 pA0, pA1, pB0, pB1; float mnA, mnB, alA, alB; bf16x8 pa0, pa1, pa2, pa3; const int NT = seq / KVBLK;
    constexpr int SE = 0, SO = 1;
    SLOAD(SE, 0); asm volatile("s_waitcnt vmcnt(0)" ::: "memory"); SWRITE(0, SE); __syncthreads();
    qkt(pA0, pA1, K_lds, qr, r32, hi); partialSM(pA0, pA1, m_reg, mnA, alA);
    SLOAD(SO, KVBLK); if (2 < NT) SLOAD(SE, 2 * KVBLK);
    SWAIT(); SWRITE(1, SO); __syncthreads();
    for (int j = 1; j + 1 < NT; j += 2) {
        SBAR(); qkt(pB0, pB1, K_lds + SHM_K, qr, r32, hi);
        finishSM(pA0, pA1, alA, l_reg, pa0, pa1, pa2, pa3); SBAR();
        SLOAD(SO, (j + 2) * KVBLK); SBAR();
        pv_d0(o, vb0, pa0, pa1, pa2, pa3); partialSM(pB0, pB1, m_reg, mnB, alB);
        __syncthreads(); SWAIT(); SWRITE(0, SE);
        RESC(alB); __syncthreads();
        SBAR(); qkt(pA0, pA1, K_lds, qr, r32, hi);
        finishSM(pB0, pB1, alB, l_reg, pa0, pa1, pa2, pa3); SBAR();
        if (j + 3 < NT) SLOAD(SE, (j + 3) * KVBLK); SBAR();
        pv_d0(o, vb0 + (int)SHM_V, pa0, pa1, pa2, pa3); partialSM(pA0, pA1, m_reg, mnA, alA);
        __syncthreads(); SWAIT(); SWRITE(1, SO);
        RESC(alA); __syncthreads();
    }
    SBAR(); qkt(pB0, pB1, K_lds + SHM_K, qr, r32, hi);
    finishSM(pA0, pA1, alA, l_reg, pa0, pa1, pa2, pa3); SBAR();
    pv_d0(o, vb0, pa0, pa1, pa2, pa3); partialSM(pB0, pB1, m_reg, mnB, alB);
    __syncthreads(); RESC(alB);
    finishSM(pB0, pB1, alB, l_reg, pa0, pa1, pa2, pa3); SBAR();
    pv_d0(o, vb0 + (int)SHM_V, pa0, pa1, pa2, pa3);
    if (hi == 0) li_l[r32] = l_reg; asm volatile("s_waitcnt lgkmcnt(0)" ::: "memory");
    float rli[16];
#pragma unroll
    for (int r = 0; r < 16; ++r) rli[r] = __builtin_amdgcn_rcpf(li_l[crow(r, hi)]);
    bf16_t* Ow = Ob + (long)(wid * QBLK) * LDO;
#pragma unroll
    for (int r = 0; r < 16; ++r) { int orow = crow(r, hi);
#pragma unroll
        for (int d0 = 0; d0 < 4; ++d0) Ow[(long)orow * LDO + d0 * 32 + r32] = (bf16_t)f2bf(o[d0][r] * rli[r]); }
#undef SLOAD
#undef SWRITE
#undef SWAIT
#undef RESC
}
}

struct Args {
    const float* x; const float* c; const float* ctx; const float* c_ctx; const float* mod_w; const float* mod_b;
    const float* norm1_g; const float* norm2_g; const float* ab_w_in; const float* ab_w_out; const float* ret_decay;
    const float* q_g; const float* k_g; const float* cm_w_in; const float* cm_v_g; const float* cm_w_s; const float* cm_b_s;
    const float* cm_w_out; const float* ff_w1; const float* ff_w2;
    float* out; unsigned char* ws; int ph_lo, ph_hi;
};

__device__ __forceinline__ void transpose_item(const float* W, int K, int N, bf16_t* WT, float* scr, int item, int lane, bool perm = false) {
    const int nblk = N / 32, kb = item / nblk, nb = item % nblk, k0 = 64 * kb, n0 = 32 * nb;
#pragma unroll 8
    for (int i = 0; i < 32; ++i) { const int kk = 2 * i + (lane >> 5); scr[kk * 33 + (lane & 31)] = W[(size_t)(k0 + kk) * N + (perm ? pg8::inproj_orig_col(n0 + (lane & 31)) : n0 + (lane & 31))]; }
    LDS_WAIT(); asm volatile("" ::: "memory");
    const int c = lane & 7;
#pragma unroll
    for (int j = 0; j < 4; ++j) { const int n = (lane >> 3) + 8 * j; const float* s = scr + (8 * c) * 33 + n;
        u32x4 o; o.x = cvtpk(s[0 * 33], s[1 * 33]); o.y = cvtpk(s[2 * 33], s[3 * 33]); o.z = cvtpk(s[4 * 33], s[5 * 33]); o.w = cvtpk(s[6 * 33], s[7 * 33]);
        *(u32x4*)(WT + (size_t)(n0 + n) * K + k0 + 8 * c) = o; }
    LDS_WAIT(); asm volatile("" ::: "memory");
}

__device__ __forceinline__ void gemv17_item(char* lds, const float* W, int ldw, float* out, int ldo, const float* bias, int j0, int wv, int permbase = -1) {
    int tid_ = (wv << 6) | lane_id(); asm volatile("" : "+v"(tid_)); const int tid = tid_, lane = tid & 63, wave = tid >> 6;
    const float* T = (const float*)lds; float* red = (float*)(lds + 81920);
    float acc[17];
#pragma unroll
    for (int jj = 0; jj < 17; ++jj) acc[jj] = 0.f;
    const float* wp = W + (size_t)(wave * 128) * ldw + (permbase >= 0 ? pg8::inproj_orig_col(permbase + lane) - permbase : lane);
#pragma unroll 1
    for (int kb = 0; kb < 128; kb += 8) {
        float wvv[8];
#pragma unroll
        for (int i = 0; i < 8; ++i) wvv[i] = wp[(size_t)(kb + i) * ldw];
#pragma unroll
        for (int i = 0; i < 8; ++i) { const float wv = wvv[i]; const float* tp = T + (wave * 128 + kb + i) * 20;
            const f32x4 t0 = *(const f32x4*)(tp), t1 = *(const f32x4*)(tp + 4), t2 = *(const f32x4*)(tp + 8), t3 = *(const f32x4*)(tp + 12); const float t16 = tp[16];
            acc[0] += t0[0] * wv; acc[1] += t0[1] * wv; acc[2] += t0[2] * wv; acc[3] += t0[3] * wv;
            acc[4] += t1[0] * wv; acc[5] += t1[1] * wv; acc[6] += t1[2] * wv; acc[7] += t1[3] * wv;
            acc[8] += t2[0] * wv; acc[9] += t2[1] * wv; acc[10] += t2[2] * wv; acc[11] += t2[3] * wv;
            acc[12] += t3[0] * wv; acc[13] += t3[1] * wv; acc[14] += t3[2] * wv; acc[15] += t3[3] * wv; acc[16] += t16 * wv; }
    }
#pragma unroll
    for (int jj = 0; jj < 17; ++jj) red[(jj * 8 + wave) * 64 + lane] = acc[jj];
    __syncthreads();
    for (int e = tid; e < 17 * 64; e += 512) { const int jj = e >> 6, ln = e & 63, j = j0 + jj; float s = 0.f;
#pragma unroll
        for (int w = 0; w < 8; ++w) s += red[(jj * 8 + w) * 64 + ln];
        if (j < 33) out[(size_t)j * ldo + ln] = s + (bias ? bias[ln] : 0.f); }
    __syncthreads();
}

__device__ __forceinline__ void transposes(const Args& a, char* lds, int G, int wv, int lo, int hi) {
    int tid_ = (wv << 6) | lane_id(); asm volatile("" : "+v"(tid_)); const int tid = tid_, lane = tid & 63, wave = tid >> 6;
    const int gw = blockIdx.x * 8 + wave, NGW = G * 8;
    unsigned char* ws = a.ws;
    float* scr = (float*)(lds + wave * 16384);
    constexpr int I_ABIN = 16 * 96, I_SQ = 16 * 32, I_CMIN = 16 * 64, I_FF = 16 * 128;
    constexpr int NITEMS = 2 * I_ABIN + 2 * I_SQ + 2 * I_CMIN + 2 * I_SQ + 4 * I_FF + 4 * I_FF;
    for (int it = lo + gw; it < (hi < NITEMS ? hi : NITEMS); it += NGW) {
        int r = it;
        if (r < 2 * I_ABIN) { const int i = r / I_ABIN; transpose_item(a.ab_w_in + (size_t)i * 1024 * 3072, 1024, 3072, (bf16_t*)(ws + WS_WABIN) + (size_t)i * 3072 * 1024, scr, r % I_ABIN, lane, true); continue; } r -= 2 * I_ABIN;
        if (r < 2 * I_SQ) { const int i = r / I_SQ; transpose_item(a.ab_w_out + (size_t)i * 1024 * 1024, 1024, 1024, (bf16_t*)(ws + WS_WABOUT) + (size_t)i * 1024 * 1024, scr, r % I_SQ, lane); continue; } r -= 2 * I_SQ;
        if (r < 2 * I_CMIN) { const int i = r / I_CMIN; transpose_item(a.cm_w_in + (size_t)i * 1024 * 2048, 1024, 2048, (bf16_t*)(ws + WS_WCMIN) + (size_t)i * 2048 * 1024, scr, r % I_CMIN, lane); continue; } r -= 2 * I_CMIN;
        if (r < 2 * I_SQ) { const int i = r / I_SQ; transpose_item(a.cm_w_out + (size_t)i * 1024 * 1024, 1024, 1024, (bf16_t*)(ws + WS_WCMOUT) + (size_t)i * 1024 * 1024, scr, r % I_SQ, lane); continue; } r -= 2 * I_SQ;
        if (r < 4 * I_FF) { const int i = r / I_FF; transpose_item(a.ff_w1 + (size_t)i * 1024 * 4096, 1024, 4096, (bf16_t*)(ws + WS_WFF1) + (size_t)i * 4096 * 1024, scr, r % I_FF, lane); continue; } r -= 4 * I_FF;
        { const int i = r / I_FF; transpose_item(a.ff_w2 + (size_t)i * 4096 * 1024, 4096, 1024, (bf16_t*)(ws + WS_WFF2) + (size_t)i * 1024 * 4096, scr, r % I_FF, lane); }
    }
}

__device__ __forceinline__ void prologue(const Args& a, char* lds, int G, int wv) {
    int tid_ = (wv << 6) | lane_id(); asm volatile("" : "+v"(tid_)); const int tid = tid_, lane = tid & 63, wave = tid >> 6;
    const int gw = blockIdx.x * 8 + wave, NGW = G * 8;
    unsigned char* ws = a.ws;
    transposes(a, lds, G, wv, 0, 16 * 96);
    { bf16_t* wsb = (bf16_t*)(ws + WS_WSB);
      for (int i = blockIdx.x * 512 + tid; i < 2 * 8 * 128 * 128 / 2; i += G * 512) { const float2 v = ((const float2*)a.cm_w_s)[i]; ((unsigned*)wsb)[i] = cvtpk(v.x, v.y); } }
    { float* rc = (float*)(ws + WS_ROPE); float* rs = rc + 2048 * 64;
      for (int i = blockIdx.x * 512 + tid; i < 2048 * 64; i += G * 512) { const int t = i >> 6, j = i & 63; const int f = j & 31;
          const float inv = exp2f(-(float)f * (13.287712379549449f / 32.0f));
          const float pos = (j < 32) ? (float)(t >> 6) : (float)(t & 63);
          const float ang = pos * inv; rc[i] = cosf(ang); rs[i] = sinf(ang); } }
    __syncthreads();
    float* MOD = (float*)(ws + WS_MOD);
    const bool onepass = (G == 256);
#pragma unroll 1
    for (int pass = onepass ? (int)(blockIdx.x >> 7) : 0; pass < (onepass ? (int)(blockIdx.x >> 7) + 1 : 2); ++pass) {
        const int j0 = pass * 17;
        float* T = (float*)lds;
        for (int e = tid; e < 17 * 1024; e += 512) { const int jj = e >> 10, k = e & 1023, j = j0 + jj; float v = 0.f;
            if (j < 33) { const float cv = (j < 32) ? a.c[j * 1024 + k] : a.c_ctx[k]; v = cv / (1.0f + __expf(-cv)); }
            T[k * 20 + jj] = v; }
        __syncthreads();
        for (int item = onepass ? (int)(blockIdx.x & 127) : (int)blockIdx.x; item < 4 * 96; item += onepass ? 128 : G) {
            const int l = item / 96, n0 = (item % 96) * 64;
            gemv17_item(lds, a.mod_w + (size_t)l * 1024 * 6144 + n0, 6144, MOD + (size_t)l * 33 * 6144 + n0, 6144, a.mod_b + l * 6144 + n0, j0, wv);
        }
        __syncthreads();
    }
}

__device__ __forceinline__ void shw_phase(const Args& a, char* lds, int G, int wv) {
    int tid_ = (wv << 6) | lane_id(); asm volatile("" : "+v"(tid_)); const int tid = tid_;
    const float* MOD = (const float*)(a.ws + WS_MOD); float* SHW = (float*)(a.ws + WS_SHW);
    int base = 0;
#pragma unroll 1
    for (int e = 1; e < 8; ++e) {
        const int l = e >> 1, which = e & 1, li = l >> 1;
        const int N = which ? 4096 : ((l & 1) ? 2048 : 3072);
        const float* W = which ? a.ff_w1 + (size_t)l * 1024 * 4096 : ((l & 1) ? a.cm_w_in + (size_t)li * 1024 * 2048 : a.ab_w_in + (size_t)li * 1024 * 3072);
        const float* sh = MOD + (size_t)l * 33 * 6144 + which * 3072;
        const int nit = N / 64;
#pragma unroll 1
        for (int pass = 0; pass < 2; ++pass) {
            const int first = ((blockIdx.x - base) % G + G) % G;
            if (first < nit) {
                const int j0 = pass * 17; float* T = (float*)lds;
                __syncthreads();
                for (int x = tid; x < 17 * 1024; x += 512) { const int jj = x >> 10, k = x & 1023, j = j0 + jj; T[k * 20 + jj] = (j < 33) ? sh[(size_t)j * 6144 + k] : 0.f; }
                __syncthreads();
                for (int it = first; it < nit; it += G)
                    gemv17_item(lds, W + it * 64, N, SHW + (size_t)e * 33 * 4096 + it * 64, 4096, nullptr, j0, wv, (which == 0 && (l & 1) == 0) ? it * 64 : -1);
            }
            base += nit;
        }
    }
    __syncthreads();
}

__device__ __forceinline__ void norm_phase(const float* xlat, const float* xctx, const float* g, const float* modl, int which, bf16_t* XN, int Mrows, int ngw, int wv) {
    int tid_ = (wv << 6) | lane_id(); asm volatile("" : "+v"(tid_)); const int lane = tid_ & 63, gw = blockIdx.x * 8 + (tid_ >> 6);
    for (int r = gw; r < Mrows; r += ngw) {
        const float* src = r < RLAT ? xlat + (size_t)r * 1024 : xctx + (size_t)(r - RLAT) * 1024;
        const int bidx = r < RLAT ? (r >> 11) : 32;
        const float* mp = modl + (size_t)bidx * 6144 + which * 3072;
        f32x4 v[4]; float s = 0.f;
#pragma unroll
        for (int j = 0; j < 4; ++j) { v[j] = ((const f32x4*)src)[lane + 64 * j]; s += (v[j][0] * v[j][0] + v[j][1] * v[j][1]) + (v[j][2] * v[j][2] + v[j][3] * v[j][3]); }
        const float rinv = rsqrtf(wave_sum(s) * (1.0f / 1024.0f) + EPS);
        u32x2* o8 = (u32x2*)(XN + (size_t)r * 1024);
#pragma unroll
        for (int j = 0; j < 4; ++j) { const int c4 = lane + 64 * j; const f32x4 gv = ((const f32x4*)g)[c4], sh = ((const f32x4*)mp)[c4], sc = ((const f32x4*)(mp + 1024))[c4];
            const f32x4 y = (v[j] * rinv * gv) * (sc + 1.0f) + sh; u32x2 w; w.x = cvtpk(y[0], y[1]); w.y = cvtpk(y[2], y[3]); o8[c4] = w; }
    }
}

struct RnRow { bf16x8 a1, a2, b1, b2; f32x4 c0, c1, s0, s1; };
__device__ __forceinline__ RnRow rn_load(const bf16_t* P, const float* ropec, const float* ropes, int r, int col0, int col1, int sub) {
    RnRow d; const bf16_t* prow = P + (size_t)r * NIN;
    d.a1 = *reinterpret_cast<const bf16x8*>(prow + col0); d.a2 = *reinterpret_cast<const bf16x8*>(prow + col0 + 64);
    d.b1 = *reinterpret_cast<const bf16x8*>(prow + col1); d.b2 = *reinterpret_cast<const bf16x8*>(prow + col1 + 64);
    const int t = r & 2047;
    d.c0 = *(const f32x4*)(ropec + t * 64 + sub * 8); d.c1 = *(const f32x4*)(ropec + t * 64 + sub * 8 + 4);
    d.s0 = *(const f32x4*)(ropes + t * 64 + sub * 8); d.s1 = *(const f32x4*)(ropes + t * 64 + sub * 8 + 4);
    return d;
}
__device__ __forceinline__ void rn_process(bf16_t* P, int r, const RnRow& d, int col0, int col1, int hs, float mul0, const float (&ga1)[8], const float (&ga2)[8]) {
    bf16_t* prow = P + (size_t)r * NIN; const bool lat = r < RLAT;
    float cs[8], sn[8];
#pragma unroll
    for (int e = 0; e < 4; ++e) { cs[e] = lat ? d.c0[e] : 1.f; cs[4 + e] = lat ? d.c1[e] : 1.f; sn[e] = lat ? d.s0[e] : 0.f; sn[4 + e] = lat ? d.s1[e] : 0.f; }
    if (lat || hs >= 4) { float o1[8], o2[8];
#pragma unroll
        for (int e = 0; e < 8; ++e) { const float x1 = bf2f((bf16_t)d.a1[e]) * mul0, x2 = bf2f((bf16_t)d.a2[e]) * mul0; o1[e] = x1 * cs[e] - x2 * sn[e]; o2[e] = x1 * sn[e] + x2 * cs[e]; }
        u32x4 w1, w2; w1.x = cvtpk(o1[0], o1[1]); w1.y = cvtpk(o1[2], o1[3]); w1.z = cvtpk(o1[4], o1[5]); w1.w = cvtpk(o1[6], o1[7]);
        w2.x = cvtpk(o2[0], o2[1]); w2.y = cvtpk(o2[2], o2[3]); w2.z = cvtpk(o2[4], o2[5]); w2.w = cvtpk(o2[6], o2[7]);
        *(u32x4*)(prow + col0) = w1; *(u32x4*)(prow + col0 + 64) = w2; }
    { float y1[8], y2[8]; float ss = 0.f;
#pragma unroll
      for (int e = 0; e < 8; ++e) { y1[e] = bf2f((bf16_t)d.b1[e]); y2[e] = bf2f((bf16_t)d.b2[e]); ss += y1[e] * y1[e] + y2[e] * y2[e]; }
      ss += shx(ss, 1); ss += shx(ss, 2); ss += shx(ss, 4);
      const float rinv = rsqrtf(ss * (1.0f / 128.0f) + EPS);
      if (hs < 6) { float o1[8], o2[8];
#pragma unroll
        for (int e = 0; e < 8; ++e) { const float x1 = y1[e] * rinv * ga1[e], x2 = y2[e] * rinv * ga2[e]; o1[e] = x1 * cs[e] - x2 * sn[e]; o2[e] = x1 * sn[e] + x2 * cs[e]; }
        u32x4 w1, w2; w1.x = cvtpk(o1[0], o1[1]); w1.y = cvtpk(o1[2], o1[3]); w1.z = cvtpk(o1[4], o1[5]); w1.w = cvtpk(o1[6], o1[7]);
        w2.x = cvtpk(o2[0], o2[1]); w2.y = cvtpk(o2[2], o2[3]); w2.z = cvtpk(o2[4], o2[5]); w2.w = cvtpk(o2[6], o2[7]);
        *(u32x4*)(prow + col1) = w1; *(u32x4*)(prow + col1 + 64) = w2; } }
}
__device__ __forceinline__ void ropenorm_phase(bf16_t* P, const float* ropec, const float* ropes, const float* qg, const float* kg, int ngw, bool dry, int wv) {
    int tid_ = (wv << 6) | lane_id(); asm volatile("" : "+v"(tid_)); const int lane = tid_ & 63, gw = blockIdx.x * 8 + (tid_ >> 6);
    (void)dry;
    const int sub = lane & 7, hs = lane >> 3;
    float ga1[8], ga2[8];
    { const float* gsel = hs < 4 ? qg : kg;
#pragma unroll
      for (int e = 0; e < 8; ++e) { ga1[e] = gsel[sub * 8 + e]; ga2[e] = gsel[64 + sub * 8 + e]; } }
    const int col0 = (hs < 4 ? hs * 128 : 512 + (hs - 4) * 128) + sub * 8;
    const int col1 = (hs < 4 ? 2048 + hs * 128 : 2560 + ((hs - 4) & 1) * 128) + sub * 8;
    const float mul0 = hs < 4 ? 1.0f : 0.088388347648318440f;
    for (int r = gw; r < RTOT; r += 2 * ngw) {
        const int r2 = r + ngw; const bool has2 = r2 < RTOT;
        const RnRow d0 = rn_load(P, ropec, ropes, r, col0, col1, sub);
        const RnRow d1 = rn_load(P, ropec, ropes, has2 ? r2 : r, col0, col1, sub);
        rn_process(P, r, d0, col0, col1, hs, mul0, ga1, ga2);
        if (has2) rn_process(P, r2, d1, col0, col1, hs, mul0, ga1, ga2);
    }
}

__device__ __forceinline__ int chunk_rowbase(int b, int cid) { return cid < 2 ? RLAT + b * 256 + cid * 128 : b * 2048 + (cid - 2) * 128; }

__device__ __forceinline__ void ret_state_unit(const bf16_t* P, bf16_t* ST, int b, int h, int dir, float lg2, char* lds, int wv) {
    int tid_ = (wv << 6) | lane_id(); asm volatile("" : "+v"(tid_)); const int tid = tid_, wid = tid >> 6, lane = tid & 63, r32 = lane & 31, hi = lane >> 5;
    const int db = wid & 3, eh = wid >> 2;
    const int sr = tid >> 4, sc = (tid & 15) * 8;
    char* Kt = lds; char* Vt = lds + 32768;
    const int vbA = (int)(uintptr_t)Kt + v_rd_base(lane) + db * 512;
    const int vbB = (int)(uintptr_t)Vt + v_rd_base(lane) + eh * 1024;
    const float cd = exp2f(128.0f * lg2);
    f32x16 st[2] = {};
    bf16_t* STu = ST + (size_t)((b * 4 + h) * 2 + dir) * 18 * 16384;
    bf16x8 kvN[4], vvN[4];
#define RS_LOAD(CID) do { const int rb_ = chunk_rowbase(b, (CID)); _Pragma("unroll") for (int q = 0; q < 4; ++q) { const bf16_t* pr = P + (size_t)(rb_ + q * 32 + sr) * NIN + h * 128 + sc; \
        kvN[q] = *reinterpret_cast<const bf16x8*>(pr + 512); vvN[q] = *reinterpret_cast<const bf16x8*>(pr + 1024); } } while (0)
    RS_LOAD(dir == 0 ? 0 : 1);
#pragma unroll 1
    for (int s = 0; s < 18; ++s) {
        const int cid = dir == 0 ? s : (s == 0 ? 1 : (s == 1 ? 0 : 19 - s));
        bf16_t* Sp = STu + (size_t)cid * 16384;
#pragma unroll
        for (int t = 0; t < 2; ++t)
#pragma unroll
            for (int rg = 0; rg < 4; ++rg) { const int e = (2 * eh + t) * 32 + r32, d = db * 32 + 8 * rg + 4 * hi;
                u32x2 w; w.x = cvtpk(st[t][4 * rg + 0], st[t][4 * rg + 1]); w.y = cvtpk(st[t][4 * rg + 2], st[t][4 * rg + 3]); *(u32x2*)(Sp + e * 128 + d) = w; }
        if (s == 17) break;
        __syncthreads();
#pragma unroll
        for (int q = 0; q < 4; ++q) { const int key = q * 32 + sr; const bf16x8 kv = kvN[q], vv = vvN[q];
            const float kd = exp2f(lg2 * (float)(dir ? key : 127 - key));
            u32x4 w;
            w.x = cvtpk(bf2f((bf16_t)vv[0]) * kd, bf2f((bf16_t)vv[1]) * kd); w.y = cvtpk(bf2f((bf16_t)vv[2]) * kd, bf2f((bf16_t)vv[3]) * kd);
            w.z = cvtpk(bf2f((bf16_t)vv[4]) * kd, bf2f((bf16_t)vv[5]) * kd); w.w = cvtpk(bf2f((bf16_t)vv[6]) * kd, bf2f((bf16_t)vv[7]) * kd);
            const int off = (key >> 6) * 16384 + v_st(key & 63, sc);
            *(bf16x8*)(Kt + off) = kv; *(u32x4*)(Vt + off) = w; }
        __syncthreads();
        if (s + 1 < 17) { const int s1 = s + 1; RS_LOAD(dir == 0 ? s1 : (s1 == 1 ? 0 : 19 - s1)); }
        f32x16 acc[2] = {};
#pragma unroll
        for (int tile = 0; tile < 2; ++tile) {
#define RS_STEP(KS) do { const s16x4 al = tr_read<v_rd_off(0, KS, 0)>(vbA + tile * 16384), ah = tr_read<v_rd_off(0, KS, 1)>(vbA + tile * 16384); \
            const s16x4 b0l = tr_read<v_rd_off(0, KS, 0)>(vbB + tile * 16384), b0h = tr_read<v_rd_off(0, KS, 1)>(vbB + tile * 16384); \
            const s16x4 b1l = tr_read<v_rd_off(1, KS, 0)>(vbB + tile * 16384), b1h = tr_read<v_rd_off(1, KS, 1)>(vbB + tile * 16384); \
            asm volatile("s_waitcnt lgkmcnt(0)" ::: "memory"); SBAR(); \
            acc[0] = __builtin_amdgcn_mfma_f32_32x32x16_bf16(PKLH(al, ah), PKLH(b0l, b0h), acc[0], 0, 0, 0); \
            acc[1] = __builtin_amdgcn_mfma_f32_32x32x16_bf16(PKLH(al, ah), PKLH(b1l, b1h), acc[1], 0, 0, 0); } while (0)
            RS_STEP(0); RS_STEP(1); RS_STEP(2); RS_STEP(3);
#undef RS_STEP
        }
#pragma unroll
        for (int t = 0; t < 2; ++t)
#pragma unroll
            for (int r = 0; r < 16; ++r) st[t][r] = st[t][r] * cd + acc[t][r];
    }
    __syncthreads();
#undef RS_LOAD
}

__device__ __forceinline__ void ret_out_unit(const bf16_t* P, const bf16_t* ST, bf16_t* O, int b, int h, int cid, float lgf, float lgb, char* lds, int wv) {
    int tid_ = (wv << 6) | lane_id(); asm volatile("" : "+v"(tid_)); const int tid = tid_, wid = tid >> 6, lane = tid & 63, r32 = lane & 31, hi = lane >> 5;
    const int rb = wid & 3, eh = wid >> 2;
    const int sr = tid >> 4, sc = (tid & 15) * 8;
    char* Kt = lds; char* Vt = lds + 32768; char* Sf = lds + 65536; char* Sb = lds + 98304;
    const int rowbase = chunk_rowbase(b, cid);
    const bf16_t* Sfg = ST + (size_t)(((b * 4 + h) * 2 + 0) * 18 + cid) * 16384;
    const bf16_t* Sbg = ST + (size_t)(((b * 4 + h) * 2 + 1) * 18 + cid) * 16384;
    __syncthreads();
#pragma unroll
    for (int q = 0; q < 4; ++q) { const int key = q * 32 + sr; const bf16_t* pr = P + (size_t)(rowbase + key) * NIN + h * 128 + sc;
        const bf16x8 kv = __builtin_nontemporal_load(reinterpret_cast<const bf16x8*>(pr + 512)); const bf16x8 vv = __builtin_nontemporal_load(reinterpret_cast<const bf16x8*>(pr + 1024));
        const bf16x8 sf = __builtin_nontemporal_load(reinterpret_cast<const bf16x8*>(Sfg + key * 128 + sc)); const bf16x8 sb = __builtin_nontemporal_load(reinterpret_cast<const bf16x8*>(Sbg + key * 128 + sc));
        *(bf16x8*)(Kt + (key >> 6) * 16384 + KSWZ(key & 63, sc * 2)) = kv;
        *(bf16x8*)(Vt + (key >> 6) * 16384 + v_st(key & 63, sc)) = vv;
        *(bf16x8*)(Sf + KSWZ(key, sc * 2)) = sf; *(bf16x8*)(Sb + KSWZ(key, sc * 2)) = sb; }
    bf16x8 qr[8];
    { const bf16_t* Qw = P + (size_t)(rowbase + rb * 32 + r32) * NIN + h * 128 + hi * 8;
#pragma unroll
      for (int d0 = 0; d0 < 8; ++d0) qr[d0] = *reinterpret_cast<const bf16x8*>(Qw + d0 * 16); }
    __syncthreads();
    f32x16 o[2] = {}, xf[2] = {}, xb[2] = {};
    const int irow = rb * 32 + r32;
    const int vb = (int)(uintptr_t)Vt + v_rd_base(lane) + eh * 1024;
#pragma unroll
    for (int jt = 0; jt < 2; ++jt) {
        f32x16 p0, p1; qkt(p0, p1, Kt + jt * 16384, qr, r32, hi);
#pragma unroll
        for (int r = 0; r < 16; ++r) { const int j0 = jt * 64 + crow(r, hi), d0 = irow - j0, d1 = d0 - 32;
            const float w0 = d0 > 0 ? exp2f(lgf * (float)d0) : (d0 < 0 ? exp2f(lgb * (float)(-d0)) : 2.0f);
            const float w1 = d1 > 0 ? exp2f(lgf * (float)d1) : (d1 < 0 ? exp2f(lgb * (float)(-d1)) : 2.0f);
            p0[r] *= w0; p1[r] *= w1; }
        bf16x8 pa0, pa1, pa2, pa3; pack_p(p0, p1, pa0, pa1, pa2, pa3);
        pv_one<0>(o[0], vb + jt * 16384, pa0, pa1, pa2, pa3); pv_one<1>(o[1], vb + jt * 16384, pa0, pa1, pa2, pa3);
    }
#pragma unroll
    for (int t = 0; t < 2; ++t)
#pragma unroll
        for (int d0 = 0; d0 < 8; ++d0) { const int e = (2 * eh + t) * 32 + r32, cb = (d0 * 16 + hi * 8) * 2;
            const bf16x8 bf = *reinterpret_cast<const bf16x8*>(Sf + KSWZ(e, cb)); const bf16x8 bb = *reinterpret_cast<const bf16x8*>(Sb + KSWZ(e, cb));
            xf[t] = __builtin_amdgcn_mfma_f32_32x32x16_bf16(qr[d0], bf, xf[t], 0, 0, 0);
            xb[t] = __builtin_amdgcn_mfma_f32_32x32x16_bf16(qr[d0], bb, xb[t], 0, 0, 0); }
    __syncthreads();
    float* OT = (float*)lds;
#pragma unroll
    for (int r = 0; r < 16; ++r) { const int i = rb * 32 + crow(r, hi); const float wf = exp2f(lgf * (float)(i + 1)), wb = exp2f(lgb * (float)(128 - i));
#pragma unroll
        for (int t = 0; t < 2; ++t) OT[i * 132 + (2 * eh + t) * 32 + r32] = o[t][r] + wf * xf[t][r] + wb * xb[t][r]; }
    __syncthreads();
    { const int row = tid >> 2, qd = tid & 3; const float* op = OT + row * 132 + qd * 32; f32x4 v[8]; float s = 0.f;
#pragma unroll
      for (int j = 0; j < 8; ++j) { v[j] = *(const f32x4*)(op + 4 * j); s += (v[j][0] + v[j][1]) + (v[j][2] + v[j][3]); }
      s += shx(s, 1); s += shx(s, 2); const float mu = s * (1.0f / 128.0f); float q = 0.f;
#pragma unroll
      for (int j = 0; j < 8; ++j) { v[j] = v[j] - mu; q += (v[j][0] * v[j][0] + v[j][1] * v[j][1]) + (v[j][2] * v[j][2] + v[j][3] * v[j][3]); }
      q += shx(q, 1); q += shx(q, 2); const float rstd = rsqrtf(q * (1.0f / 128.0f) + EPS);
      const bf16_t* gp = P + (size_t)(rowbase + row) * NIN + 1536 + h * 128 + qd * 32; bf16_t* od = O + (size_t)(rowbase + row) * DM + h * 128 + qd * 32;
#pragma unroll
      for (int j = 0; j < 4; ++j) { const bf16x8 gv = *reinterpret_cast<const bf16x8*>(gp + 8 * j); float y[8];
#pragma unroll
          for (int e = 0; e < 8; ++e) { const float g = bf2f((bf16_t)gv[e]); const float sg = g / (1.0f + __expf(-g)); y[e] = v[2 * j + (e >> 2)][e & 3] * rstd * sg; }
          u32x4 w; w.x = cvtpk(y[0], y[1]); w.y = cvtpk(y[2], y[3]); w.z = cvtpk(y[4], y[5]); w.w = cvtpk(y[6], y[7]); *(u32x4*)(od + 8 * j) = w; } }
}

__device__ __forceinline__ void gate_unit(const bf16_t* Z, const float* ssq, const float* vg, const bf16_t* wsb, const float* bs, bf16_t* Gout, int chunk, int gbase, char* lds, int wv) {
    int tid_ = (wv << 6) | lane_id(); asm volatile("" : "+v"(tid_)); const int tid = tid_, wid = tid >> 6, lane = tid & 63, r32 = lane & 31, hi = lane >> 5;
    const int pb = wid & 3, dh = wid >> 2;
    const int sr = tid >> 4, sc = (tid & 15) * 8;
    const int rowbase = chunk * 128;
    char* Vt = lds;
    bf16x8 af[2][8];
#pragma unroll
    for (int gg = 0; gg < 2; ++gg) { const bf16_t* wp = wsb + (size_t)((gbase + gg) * 128 + pb * 32 + r32) * 128 + hi * 8;
#pragma unroll
      for (int k8 = 0; k8 < 8; ++k8) af[gg][k8] = *reinterpret_cast<const bf16x8*>(wp + k8 * 16); }
    f32x4 gsc[2][2];
#pragma unroll
    for (int gg = 0; gg < 2; ++gg) { gsc[gg][0] = *(const f32x4*)(vg + (gbase + gg) * 128 + sc); gsc[gg][1] = *(const f32x4*)(vg + (gbase + gg) * 128 + sc + 4); }
    __syncthreads();
#pragma unroll
    for (int q = 0; q < 4; ++q) { const int key = q * 32 + sr; const int row = rowbase + key;
        const bf16x8 vv0 = __builtin_nontemporal_load(reinterpret_cast<const bf16x8*>(Z + (size_t)row * 2048 + 1024 + gbase * 128 + sc));
        const bf16x8 vv1 = __builtin_nontemporal_load(reinterpret_cast<const bf16x8*>(Z + (size_t)row * 2048 + 1024 + (gbase + 1) * 128 + sc));
        const f32x4 s0 = *(const f32x4*)(ssq + (size_t)row * 16), s1 = *(const f32x4*)(ssq + (size_t)row * 16 + 4), s2 = *(const f32x4*)(ssq + (size_t)row * 16 + 8), s3 = *(const f32x4*)(ssq + (size_t)row * 16 + 12);
        const float tot = ((s0[0] + s0[1]) + (s0[2] + s0[3])) + ((s1[0] + s1[1]) + (s1[2] + s1[3])) + ((s2[0] + s2[1]) + (s2[2] + s2[3])) + ((s3[0] + s3[1]) + (s3[2] + s3[3]));
        const float rinv = rsqrtf(tot * (1.0f / 1024.0f) + EPS);
#pragma unroll
        for (int gg = 0; gg < 2; ++gg) { const bf16x8 vv = gg ? vv1 : vv0; const f32x4 g0 = gsc[gg][0], g1 = gsc[gg][1];
            u32x4 w;
            w.x = cvtpk(bf2f((bf16_t)vv[0]) * rinv * g0[0], bf2f((bf16_t)vv[1]) * rinv * g0[1]); w.y = cvtpk(bf2f((bf16_t)vv[2]) * rinv * g0[2], bf2f((bf16_t)vv[3]) * rinv * g0[3]);
            w.z = cvtpk(bf2f((bf16_t)vv[4]) * rinv * g1[0], bf2f((bf16_t)vv[5]) * rinv * g1[1]); w.w = cvtpk(bf2f((bf16_t)vv[6]) * rinv * g1[2], bf2f((bf16_t)vv[7]) * rinv * g1[3]);
            *(u32x4*)(Vt + gg * 32768 + (key >> 6) * 16384 + v_st(key & 63, sc)) = w; } }
    __syncthreads();
    f32x16 acc[2][2] = {};
    const int vb = (int)(uintptr_t)Vt + v_rd_base(lane) + dh * 1024;
#pragma unroll
    for (int gg = 0; gg < 2; ++gg)
#pragma unroll
    for (int tile = 0; tile < 2; ++tile) {
#define GT_STEP(KS) do { const int vbt = vb + gg * 32768 + tile * 16384; const s16x4 b0l = tr_read<v_rd_off(0, KS, 0)>(vbt), b0h = tr_read<v_rd_off(0, KS, 1)>(vbt); \
        const s16x4 b1l = tr_read<v_rd_off(1, KS, 0)>(vbt), b1h = tr_read<v_rd_off(1, KS, 1)>(vbt); \
        asm volatile("s_waitcnt lgkmcnt(0)" ::: "memory"); SBAR(); \
        acc[gg][0] = __builtin_amdgcn_mfma_f32_32x32x16_bf16(af[gg][tile * 4 + KS], PKLH(b0l, b0h), acc[gg][0], 0, 0, 0); \
        acc[gg][1] = __builtin_amdgcn_mfma_f32_32x32x16_bf16(af[gg][tile * 4 + KS], PKLH(b1l, b1h), acc[gg][1], 0, 0, 0); } while (0)
        GT_STEP(0); GT_STEP(1); GT_STEP(2); GT_STEP(3);
#undef GT_STEP
    }
#pragma unroll
    for (int gg = 0; gg < 2; ++gg) { const int g = gbase + gg;
#pragma unroll
    for (int r = 0; r < 16; ++r) { const int p = pb * 32 + crow(r, hi); const float bias = bs[g * 128 + p];
        const bf16_t* up = Z + (size_t)(rowbase + p) * 2048 + g * 128; bf16_t* gp = Gout + (size_t)(rowbase + p) * DM + g * 128;
#pragma unroll
        for (int t = 0; t < 2; ++t) { const int d = (2 * dh + t) * 32 + r32; gp[d] = (bf16_t)f2bf(bf2f(up[d]) * (acc[gg][t][r] + bias)); } } }
}


#ifdef NO_ATT
#define PH_ATT(...) do {} while (0)
#else
#define PH_ATT(...) __VA_ARGS__
#endif
#ifdef NO_RS
#define PH_RS(...) do {} while (0)
#else
#define PH_RS(...) __VA_ARGS__
#endif
#ifdef NO_RO
#define PH_RO(...) do {} while (0)
#else
#define PH_RO(...) __VA_ARGS__
#endif
#ifdef NO_GT
#define PH_GT(...) do {} while (0)
#else
#define PH_GT(...) __VA_ARGS__
#endif
#ifdef NO_PRO
#define PH_PRO(...) do {} while (0)
#else
#define PH_PRO(...) __VA_ARGS__
#endif
#ifdef NO_GEMM
#define PH_GEMM(...) do {} while (0)
#else
#define PH_GEMM(...) __VA_ARGS__
#endif

#ifndef DUPMASK
#define DUPMASK 0
#endif
#ifndef DUPSYNC
#define DUPSYNC 0
#endif
#ifndef DUPGATE
#define DUPGATE 0
#endif
#define GSYNC() do { XcdBarrier b_; b_.bar = barp; asm volatile("" : "+s"(b_.bar)); unsigned x_ = xb_xcc_id(); asm volatile("" : "+s"(x_)); b_.x = x_; b_.st = bst; xcd_barrier(b_, (wv == 0) && (lane_id() == 0)); if (DUPSYNC) xcd_barrier(b_, (wv == 0) && (lane_id() == 0)); } while (0)
#define REPS(id) ((((DUPMASK) >> (id)) & 1) ? 2 : 1)
#define XB_TMO      128
#define XB_XCNT(j)  (256  + 64 * (j))
#define XB_XSUB(j)  (1280 + 64 * (j))
#define XB_XGEN(j)  (2304 + 64 * (j))
#define XB_TOP      3328
#define XB_TOPGEN   3392
#define XCD_BAR_WORDS 3456
#define XB_SPIN_CAP (1u << 18)

__device__ __forceinline__ unsigned xb_ld(unsigned* p)              { return __hip_atomic_load(p, __ATOMIC_RELAXED, __HIP_MEMORY_SCOPE_AGENT); }
__device__ __forceinline__ unsigned xb_add(unsigned* p, unsigned v) { return __hip_atomic_fetch_add(p, v, __ATOMIC_RELAXED, __HIP_MEMORY_SCOPE_AGENT); }
__device__ __forceinline__ unsigned xb_xcc_id() { return (unsigned)__builtin_amdgcn_s_getreg((3 << 11) | 20) & 0xFu; }
#define XB_SPIN(cond, bar) do { unsigned _sp = 0; while (cond) { __builtin_amdgcn_s_sleep(1); \
    if ((++_sp & 255u) == 0u) { if (xb_ld(&(bar)[XB_TMO])) break; if (_sp > XB_SPIN_CAP) { atomicAdd(&(bar)[XB_TMO], 1u); break; } } } } while (0)

struct XcdBarrier {
    unsigned* bar; unsigned x;
    volatile __attribute__((address_space(3))) unsigned* st;
};

__device__ __forceinline__ XcdBarrier xcd_barrier_post(unsigned* bar, volatile __attribute__((address_space(3))) unsigned* st) {
    XcdBarrier b; b.bar = bar; b.x = xb_xcc_id(); b.st = st;
    if (threadIdx.x == 0) (void)xb_add(&bar[XB_XCNT(b.x)], 1u);
    return b;
}
__device__ __forceinline__ void xcd_barrier_complete(unsigned* bar, unsigned x, unsigned& nloc, unsigned& nx) {
    const unsigned G = gridDim.x * gridDim.y * gridDim.z;
    unsigned sum, cnt, mine, sp = 0u;
    for (;;) {
        sum = 0u; cnt = 0u; mine = 0u;
#pragma unroll
        for (unsigned j = 0; j < 16; ++j) { const unsigned c = xb_ld(&bar[XB_XCNT(j)]); sum += c; cnt += (c > 0u) ? 1u : 0u; mine = (j == x) ? c : mine; }
        if (sum == G) break;
        __builtin_amdgcn_s_sleep(1);
        if ((++sp & 255u) == 0u) { if (xb_ld(&bar[XB_TMO])) break; if (sp > XB_SPIN_CAP) { atomicAdd(&bar[XB_TMO], 1u); break; } }
    }
    nloc = mine > 0u ? mine : 1u; nx = cnt > 0u ? cnt : 1u;
}

__device__ __forceinline__ void xcd_barrier(const XcdBarrier& b, bool leader_thread) {
    asm volatile("s_waitcnt vmcnt(0)" ::: "memory");
    __syncthreads();
    if (leader_thread) {
        unsigned* bar = b.bar;
        __builtin_amdgcn_s_waitcnt(0);
        unsigned nloc = b.st[0], nx = b.st[1];
        if (nloc == 0u) { xcd_barrier_complete(bar, b.x, nloc, nx); b.st[0] = nloc; b.st[1] = nx; }
        const unsigned old = xb_add(&bar[XB_XSUB(b.x)], 1u);
        const unsigned gen = old / nloc;
        if (old + 1u == (gen + 1u) * nloc) {
            __builtin_amdgcn_fence(__ATOMIC_RELEASE, "agent");
            asm volatile("s_waitcnt vmcnt(0)" ::: "memory");
            const unsigned og = xb_add(&bar[XB_TOP], 1u);
            const unsigned tg = og / nx;
            if (og + 1u == (tg + 1u) * nx) xb_add(&bar[XB_TOPGEN], 1u);
            else XB_SPIN(xb_ld(&bar[XB_TOPGEN]) == tg, bar);
            __builtin_amdgcn_fence(__ATOMIC_ACQUIRE, "agent");
            xb_add(&bar[XB_XGEN(b.x)], 1u);
            asm volatile("s_waitcnt vmcnt(0)" ::: "memory");
        } else {
            XB_SPIN(xb_ld(&bar[XB_XGEN(b.x)]) == gen, bar);
            __builtin_amdgcn_fence(__ATOMIC_ACQUIRE, "agent");
            asm volatile("s_waitcnt vmcnt(0)" ::: "memory");
        }
    }
    __syncthreads();
}

__global__ void __launch_bounds__(512, 2) mk_fwd(Args a) {
    extern __shared__ __attribute__((aligned(16))) unsigned char lds_raw[];
    cg::grid_group grid = cg::this_grid();
    char* lds = (char*)lds_raw;
    const int G = gridDim.x, bx = blockIdx.x;
    const int NGW = G * 8;
    const int wv = __builtin_amdgcn_readfirstlane(threadIdx.x >> 6);
    unsigned char* ws = a.ws;
    float* MOD = (float*)(ws + WS_MOD);
    const float* ropec = (const float*)(ws + WS_ROPE); const float* ropes = ropec + 2048 * 64;
    bf16_t* XN = (bf16_t*)(ws + WS_XN); bf16_t* XS = (bf16_t*)(ws + WS_XS); bf16_t* BIG = (bf16_t*)(ws + WS_BIG); bf16_t* ST = (bf16_t*)(ws + WS_ST);
    float* XCTX = (float*)(ws + WS_XCTX); float* SSQ = (float*)(ws + WS_SSQ); float* SSQA = (float*)(ws + WS_SSQA); float* SSQB = (float*)(ws + WS_SSQB);
    const float* SHW = (const float*)(ws + WS_SHW);
    PG8_LAS unsigned char* glds = (PG8_LAS unsigned char*)lds_raw;
    volatile __attribute__((address_space(3))) unsigned* bst = (volatile __attribute__((address_space(3))) unsigned*)(glds + 147392);
    if (threadIdx.x < 2) bst[threadIdx.x] = 0u;
    __syncthreads();
    unsigned* barp = (unsigned*)ws + 4096;
    { XcdBarrier b0_ = xcd_barrier_post(barp, bst); (void)b0_; }

for (int rep = 0; rep < REPS(0); ++rep) {
    prologue(a, lds, G, wv);
    grid.sync();
}
for (int rep = 0; rep < REPS(1); ++rep) {
    norm_phase(a.x, a.ctx, a.norm1_g, MOD, 0, XN, RTOT, NGW, wv);
    transposes(a, lds, G, wv, 16 * 96, 1 << 30);
    __syncthreads();
    shw_phase(a, lds, G, wv);
    GSYNC();
}

#pragma unroll 1
    for (int l = 0; l < DEPTH; ++l) {
        const bool even = (l & 1) == 0; const int li = l >> 1;
        const int Mrows = (l == DEPTH - 1) ? RLAT : RTOT;
        const float* modl = MOD + (size_t)l * 33 * 6144;
        const float* xin_lat = (l == 0) ? a.x : a.out; const float* xin_ctx = (l == 0) ? a.ctx : XCTX;
        const bool ctx_post = l < 2;
        const int Mpost = ctx_post ? RTOT : RLAT;
        const bool nrm_in = l > 0;
        if (even) {
for (int rep = 0; rep < REPS(2); ++rep) {
            { const bool cl = !ctx_post && Mrows == RTOT;
              pg8::Gemm g{XN, (const bf16_t*)(ws + WS_WABIN) + (size_t)li * 3072 * 1024, Mrows, NIN, DM}; pg8::NormOrder S; S.init(cl ? RLAT : Mrows, NIN, G, bx); S.ctx_live = cl ? 32 : 0; S.ssq = SSQB; S.lds = glds; S.wv = wv; S.dummy = MOD; S.on = nrm_in; S.v0 = nrm_in ? SHW + (size_t)(2 * l) * 33 * 4096 : nullptr; S.ld0 = 4096; S.v1 = nullptr; S.v2 = nullptr; S.ld2 = 0;
              pg8::EpiInProj E{BIG, nrm_in, glds, ropec, ropes, a.q_g + li * 128, a.k_g + li * 128};
              pg8::gemm_phase<pg8::EpiInProj, pg8::NormOrder, true, true>(glds, g, S, E); }
            GSYNC();
}
            for (int rep = 0; rep < REPS(4); ++rep) {
            for (int u = bx; u < 1024 + 256 + (ctx_post ? 128 : 0); u += G) {
                if (u < 1024) {
                    const int rnd = u >> 8, v = u & 255, x = v & 7, y = v >> 3; const int grp = rnd * 16 + x * 2 + (y >> 4);
                    const int b = grp >> 1, kvh = grp & 1, h = kvh * 2 + ((y >> 3) & 1), qb = y & 7;
                    const bf16_t* Pl = BIG + (size_t)(b * 2048) * NIN; const bf16_t* Pc = BIG + (size_t)(RLAT + b * 256) * NIN;
                    attn::body(Pl + (size_t)(qb * 256) * NIN + 2048 + h * 128, Pc + 2560 + kvh * 128, Pc + 2816 + kvh * 128, 256,
                               Pl + 2560 + kvh * 128, Pl + 2816 + kvh * 128, XN + (size_t)(b * 2048 + qb * 256) * DM + 512 + h * 128, 2304, lds, wv);
                    __syncthreads();
                } else if (u < 1280) {
                    const int v = u - 1024, b = v >> 3, h = (v >> 1) & 3, dir = v & 1;
                    const float xd = a.ret_decay[(li * 2 + dir) * 4 + h]; const float lg2 = -log1pf(expf(-xd)) * 1.4426950408889634f;
                    ret_state_unit(BIG, ST, b, h, dir, lg2, lds, wv);
                } else {
                    const int v = u - 1280, b = v >> 2, h = v & 3, kvh = h >> 1;
                    const bf16_t* Pc = BIG + (size_t)(RLAT + b * 256) * NIN;
                    attn::body(Pc + 2048 + h * 128, Pc + 2560 + kvh * 128, Pc + 2816 + kvh * 128, 256, Pc, Pc, XN + (size_t)(RLAT + b * 256) * DM + 512 + h * 128, 256, lds, wv);
                    __syncthreads();
                }
            }
            GSYNC();
            }
            for (int rep = 0; rep < REPS(5); ++rep) {
            for (int u = bx; u < 32 * 4 * (ctx_post ? 18 : 16); u += G) {
                const int ncid = ctx_post ? 18 : 16; const int cid = (u % ncid) + (18 - ncid), bh = u / ncid, b = bh >> 2, h = bh & 3;
                const float xf_ = a.ret_decay[(li * 2 + 0) * 4 + h], xb_ = a.ret_decay[(li * 2 + 1) * 4 + h];
                const float lgf = -log1pf(expf(-xf_)) * 1.4426950408889634f, lgb = -log1pf(expf(-xb_)) * 1.4426950408889634f;
                ret_out_unit(BIG, ST, XN, b, h, cid, lgf, lgb, lds, wv);
            }
            __syncthreads();
            GSYNC();
            }
for (int rep = 0; rep < (DUPGATE ? 2 : 1); ++rep) { const bool dummy_ = DUPGATE && rep == 0;
            { pg8::Gemm g{XN, (const bf16_t*)(ws + WS_WABOUT) + (size_t)li * 1024 * 1024, Mpost, DM, DM}; pg8::NormOrder S; S.init(Mpost, DM, G, bx); S.ssq = nullptr; S.lds = glds; S.wv = wv; S.dummy = MOD; S.on = false; S.v0 = modl + 2048; S.ld0 = 6144; S.v1 = a.norm2_g + l * 1024; S.v2 = modl + 4096; S.ld2 = 6144;
              pg8::EpiGate E{dummy_, xin_lat, xin_ctx, a.out, XCTX, glds, true, XS, SSQA};
              pg8::gemm_phase<pg8::EpiGate, pg8::NormOrder, true, true>(glds, g, S, E); }
            GSYNC();
}
        } else {
for (int rep = 0; rep < REPS(7); ++rep) {
            { pg8::Gemm g{XN, (const bf16_t*)(ws + WS_WCMIN) + (size_t)li * 2048 * 1024, Mrows, 2048, DM}; pg8::NormOrder S; S.init(Mrows, 2048, G, bx); S.ssq = SSQB; S.lds = glds; S.wv = wv; S.dummy = MOD; S.on = true; S.v0 = SHW + (size_t)(2 * l) * 33 * 4096; S.ld0 = 4096; S.v1 = nullptr; S.v2 = nullptr; S.ld2 = 0;
              pg8::EpiBf16<1> E{BIG, 2048, SSQ, true, glds};
              pg8::gemm_phase<pg8::EpiBf16<1>, pg8::NormOrder, true, true>(glds, g, S, E); }
            GSYNC();
}
            for (int rep = 0; rep < REPS(8); ++rep) {
            for (int u = bx; u < (Mrows / 128) * 4; u += G)
                gate_unit(BIG, SSQ, a.cm_v_g + li * 1024, (const bf16_t*)(ws + WS_WSB) + (size_t)li * 8 * 128 * 128, a.cm_b_s + li * 8 * 128, XN, u >> 2, (u & 3) * 2, lds, wv);
            __syncthreads();
            GSYNC();
            }
for (int rep = 0; rep < (DUPGATE ? 2 : 1); ++rep) { const bool dummy_ = DUPGATE && rep == 0;
            { pg8::Gemm g{XN, (const bf16_t*)(ws + WS_WCMOUT) + (size_t)li * 1024 * 1024, Mrows, DM, DM}; pg8::NormOrder S; S.init(Mrows, DM, G, bx); S.ssq = nullptr; S.lds = glds; S.wv = wv; S.dummy = MOD; S.on = false; S.v0 = modl + 2048; S.ld0 = 6144; S.v1 = a.norm2_g + l * 1024; S.v2 = modl + 4096; S.ld2 = 6144;
              pg8::EpiGate E{dummy_, xin_lat, xin_ctx, a.out, XCTX, glds, true, XS, SSQA};
              pg8::gemm_phase<pg8::EpiGate, pg8::NormOrder, true, true>(glds, g, S, E); }
            GSYNC();
}
        }
for (int rep = 0; rep < REPS(11); ++rep) {
        { const int Mf = Mrows < Mpost ? Mrows : Mpost; pg8::Gemm g{XS, (const bf16_t*)(ws + WS_WFF1) + (size_t)l * 4096 * 1024, Mf, FF, DM}; pg8::NormOrder S; S.init(Mf, FF, G, bx); S.ssq = SSQA; S.lds = glds; S.wv = wv; S.dummy = MOD; S.on = true; S.v0 = SHW + (size_t)(2 * l + 1) * 33 * 4096; S.ld0 = 4096; S.v1 = nullptr; S.v2 = nullptr; S.ld2 = 0;
          pg8::EpiBf16<2> E{BIG, FF, nullptr, true, glds};
          pg8::gemm_phase<pg8::EpiBf16<2>, pg8::NormOrder, true, true>(glds, g, S, E); }
        GSYNC();
}
for (int rep = 0; rep < (DUPGATE ? 2 : 1); ++rep) { const bool dummy_ = DUPGATE && rep == 0;
        { const bool nx = l + 1 < DEPTH; const int ln = nx ? l + 1 : l;
          const int Mf = Mrows < Mpost ? Mrows : Mpost; pg8::Gemm g{BIG, (const bf16_t*)(ws + WS_WFF2) + (size_t)l * 1024 * 4096, Mf, DM, FF}; pg8::NormOrder S; S.init(Mf, DM, G, bx); S.ssq = nullptr; S.lds = glds; S.wv = wv; S.dummy = MOD; S.on = false; S.v0 = modl + 5 * 1024; S.ld0 = 6144; S.v1 = a.norm1_g + ln * 1024; S.v2 = MOD + (size_t)ln * 33 * 6144 + 1024; S.ld2 = 6144;
          pg8::EpiGate E{dummy_, a.out, XCTX, a.out, XCTX, glds, nx, XN, SSQB};
          pg8::gemm_phase<pg8::EpiGate, pg8::NormOrder, true, true>(glds, g, S, E); }
        GSYNC();
}
    }
}

extern "C" void kernel_launch(void* const* d_in, const int* in_sizes, int n_in, void* d_out, int out_size, void* d_ws, size_t ws_size, hipStream_t stream) {
    static int grid = 0;
    if (grid == 0) {
        if (n_in != 20 || out_size != RLAT * DM || ws_size < WS_END) { fprintf(stderr, "kernel_launch: unexpected shapes: n_in %d out %d ws %zu (need %zu)\n", n_in, out_size, ws_size, (size_t)WS_END); grid = -1; return; }
        int dev = 0, cus = 0, per_cu = 0;
        (void)hipGetDevice(&dev);
        (void)hipDeviceGetAttribute(&cus, hipDeviceAttributeMultiprocessorCount, dev);
        if (hipFuncSetAttribute((const void*)mk_fwd, hipFuncAttributeMaxDynamicSharedMemorySize, LDS_BYTES) != hipSuccess) { fprintf(stderr, "kernel_launch: hipFuncSetAttribute failed\n"); grid = -1; return; }
        (void)hipOccupancyMaxActiveBlocksPerMultiprocessor(&per_cu, (const void*)mk_fwd, 512, LDS_BYTES);
        if (per_cu < 1) { fprintf(stderr, "kernel_launch: occupancy query says %d blocks per CU\n", per_cu); per_cu = 1; }
        grid = cus * per_cu;
    }
    if (grid < 0) return;
    if (hipMemsetAsync((char*)d_ws + 16384, 0, 14336, stream) != hipSuccess) { fprintf(stderr, "kernel_launch: memset failed\n"); return; }
    Args a{};
    a.x = (const float*)d_in[0]; a.c = (const float*)d_in[1]; a.ctx = (const float*)d_in[2]; a.c_ctx = (const float*)d_in[3]; a.mod_w = (const float*)d_in[4]; a.mod_b = (const float*)d_in[5];
    a.norm1_g = (const float*)d_in[6]; a.norm2_g = (const float*)d_in[7]; a.ab_w_in = (const float*)d_in[8]; a.ab_w_out = (const float*)d_in[9]; a.ret_decay = (const float*)d_in[10];
    a.q_g = (const float*)d_in[11]; a.k_g = (const float*)d_in[12]; a.cm_w_in = (const float*)d_in[13]; a.cm_v_g = (const float*)d_in[14]; a.cm_w_s = (const float*)d_in[15]; a.cm_b_s = (const float*)d_in[16];
    a.cm_w_out = (const float*)d_in[17]; a.ff_w1 = (const float*)d_in[18]; a.ff_w2 = (const float*)d_in[19];
    a.out = (float*)d_out; a.ws = (unsigned char*)d_ws; a.ph_lo = 0; a.ph_hi = 0;
    void* args[] = {&a};
    hipError_t e = hipLaunchCooperativeKernel((const void*)mk_fwd, dim3(grid), dim3(512), args, LDS_BYTES, stream);
    if (e != hipSuccess) fprintf(stderr, "kernel_launch: cooperative launch failed: %s (grid %d)\n", hipGetErrorString(e), grid);
}
```
